# Optimizing an MI355X kernel written in HIP

```python
import jax, jax.numpy as jnp
from jax import lax
import numpy as np

D_MODEL = 1024
BATCH = 16
SEQ = 256
DEPTH = 2
DEC_BATCH = 4
DEC_SEQ = 1024
PAST_LEN = 512

GRID_W = 64
D_FF = 2816
FOUR_GROUPS = 4
FOUR_GROUP_DIM = 64
D_FOUR = FOUR_GROUPS * FOUR_GROUP_DIM
N_HEADS = 8
QK_NOPE = 64
QK_ROPE = 32
V_DIM = 64
Q_RANK = 384
KV_RANK = 256
N_BRANCH = 2
IN_W = D_FOUR + Q_RANK + KV_RANK + QK_ROPE + N_BRANCH * D_MODEL
N_MOD = 9
ROPE_BASE = 10000.0
EPS = 1e-6
Q_BLOCK = 128

kernel_name = "hybrid_fnet_mla_macaron_step"


def _rmsnorm(x, g):
    xf = x.astype(jnp.float32)
    y = xf * lax.rsqrt(jnp.mean(xf * xf, axis=-1, keepdims=True) + EPS)
    return (y * g.astype(jnp.float32)).astype(x.dtype)


def _swiglu(h, wg, wu, wd):
    return (jax.nn.silu(h @ wg) * (h @ wu)) @ wd


def _axial_tables(n_tok):
    rows = n_tok // GRID_W
    row = jnp.repeat(jnp.arange(rows), GRID_W).astype(jnp.float32)
    col = jnp.tile(jnp.arange(GRID_W), rows).astype(jnp.float32)
    axis_dim = QK_ROPE // 2
    inv = ROPE_BASE ** (-jnp.arange(0, axis_dim, 2, dtype=jnp.float32) / axis_dim)
    ar = row[:, None] * inv
    ac = col[:, None] * inv
    return (jnp.cos(ar), jnp.sin(ar), jnp.cos(ac), jnp.sin(ac))


def _rot_half(x, cos, sin):
    m = x.shape[-1] // 2
    x1, x2 = x[..., :m], x[..., m:]
    return jnp.concatenate([x1 * cos - x2 * sin, x2 * cos + x1 * sin], axis=-1)


def _axial_rope(x, tables):
    cr, sr, cc, sc = tables
    if x.ndim == 4:
        cr, sr, cc, sc = cr[:, None], sr[:, None], cc[:, None], sc[:, None]
    xf = x.astype(jnp.float32)
    half = QK_ROPE // 2
    out = jnp.concatenate([_rot_half(xf[..., :half], cr, sr), _rot_half(xf[..., half:], cc, sc)], axis=-1)
    return out.astype(x.dtype)


def _attend(q, k, v):
    B, N, H, Dh = q.shape
    scale = Dh ** -0.5
    nb = N // Q_BLOCK
    qb = q.reshape(B, nb, Q_BLOCK, H, Dh).swapaxes(0, 1)

    def one(qi):
        s = jnp.einsum("bqhd,bkhd->bhqk", qi, k).astype(jnp.float32) * scale
        p = jax.nn.softmax(s, axis=-1).astype(v.dtype)
        return jnp.einsum("bhqk,bkhd->bqhd", p, v)

    o = lax.map(one, qb)
    return o.swapaxes(0, 1).reshape(B, N, H, v.shape[-1])


def _mixer(h, p, tables, ctx_ckv, ctx_krope):
    B, N, _ = h.shape
    proj = h @ p["w_in"]
    cuts = [D_FOUR, D_FOUR + Q_RANK, D_FOUR + Q_RANK + KV_RANK, D_FOUR + Q_RANK + KV_RANK + QK_ROPE,
            D_FOUR + Q_RANK + KV_RANK + QK_ROPE + D_MODEL]
    f_in, q_lat, ckv, krope, g_f, g_a = jnp.split(proj, cuts, axis=-1)

    fg = f_in.reshape(B, N, FOUR_GROUPS, FOUR_GROUP_DIM).astype(jnp.float32)
    fr = jnp.real(jnp.fft.fft2(fg, axes=(1, 3), norm="ortho")).astype(h.dtype).reshape(B, N, D_FOUR)
    a_out = fr @ p["w_four"]

    q = (_rmsnorm(q_lat, p["q_norm"]) @ p["w_uq"]).reshape(B, N, N_HEADS, QK_NOPE + QK_ROPE)
    q_nope, q_rope = q[..., :QK_NOPE], q[..., QK_NOPE:]
    ckv_n = _rmsnorm(ckv, p["kv_norm"])
    if tables is not None:
        q_rope = _axial_rope(q_rope, tables)
        k_rope_own = _axial_rope(krope, tables)
    else:
        k_rope_own = krope
    key_ckv, key_rope = ckv_n, k_rope_own
    if ctx_ckv is not None:
        key_ckv = jnp.concatenate([ckv_n, ctx_ckv], axis=1)
        key_rope = jnp.concatenate([k_rope_own, ctx_krope], axis=1)
    M = key_ckv.shape[1]
    kv = (key_ckv @ p["w_ukv"]).reshape(B, M, N_HEADS, QK_NOPE + V_DIM)
    k_nope, v = kv[..., :QK_NOPE], kv[..., QK_NOPE:]
    q_full = jnp.concatenate([q_nope, q_rope], axis=-1)
    k_full = jnp.concatenate([k_nope, jnp.broadcast_to(key_rope[:, :, None, :], (B, M, N_HEADS, QK_ROPE))], axis=-1)
    o = _attend(q_full, k_full, v).reshape(B, N, N_HEADS * V_DIM) @ p["w_attn_proj"]

    merged = jax.nn.sigmoid(g_f) * a_out + jax.nn.sigmoid(g_a) * o
    return merged @ p["w_out"], ckv_n, krope


def _layer(x, mod, p, tables, ctx_ckv, ctx_krope):
    sh1, sc1, g1, sh2, sc2, g2, sh3, sc3, g3 = jnp.split(mod, N_MOD, axis=-1)
    h = _rmsnorm(x, p["norm_ffn1"]) * (1 + sc1) + sh1
    x = x + 0.5 * g1 * _swiglu(h, p["w_ffn1_gate"], p["w_ffn1_up"], p["w_ffn1_down"])
    h = _rmsnorm(x, p["norm_mix"]) * (1 + sc2) + sh2
    m, ckv_n, krope = _mixer(h, p, tables, ctx_ckv, ctx_krope)
    x = x + g2 * m
    h = _rmsnorm(x, p["norm_ffn2"]) * (1 + sc3) + sh3
    x = x + 0.5 * g3 * _swiglu(h, p["w_ffn2_gate"], p["w_ffn2_up"], p["w_ffn2_down"])
    return x, ckv_n, krope


def setup_inputs(seed: int = 0) -> dict:
    key = jax.random.key(seed)
    ks = iter(jax.random.split(key, 40))

    def nrm(shape, scale=1.0):
        return jax.random.normal(next(ks), shape, jnp.float32) * scale

    def gain(shape):
        return 1.0 + 0.05 * jax.random.normal(next(ks), shape, jnp.float32)

    L, D = DEPTH, D_MODEL
    return {
        "x_prompt": nrm((BATCH, SEQ, D)),
        "x_sample": nrm((DEC_BATCH, DEC_SEQ, D)),
        "cache_ckv": nrm((DEC_BATCH, DEPTH, PAST_LEN, KV_RANK)),
        "cache_krope": nrm((DEC_BATCH, DEPTH, PAST_LEN, QK_ROPE)),
        "c": nrm((DEC_BATCH, D)),
        "c_ctx": nrm((D,)),
        "w_mod": nrm((L, D, N_MOD * D), 0.5 * D ** -0.5),
        "b_mod": nrm((L, N_MOD * D), 0.01),
        "norm_ffn1": gain((L, D)),
        "w_ffn1_gate": nrm((L, D, D_FF), D ** -0.5),
        "w_ffn1_up": nrm((L, D, D_FF), D ** -0.5),
        "w_ffn1_down": nrm((L, D_FF, D), D_FF ** -0.5),
        "norm_mix": gain((L, D)),
        "w_in": nrm((L, D, IN_W), D ** -0.5),
        "w_four": nrm((L, D_FOUR, D), D_FOUR ** -0.5),
        "q_norm": gain((L, Q_RANK)),
        "w_uq": nrm((L, Q_RANK, N_HEADS * (QK_NOPE + QK_ROPE)), Q_RANK ** -0.5),
        "kv_norm": gain((L, KV_RANK)),
        "w_ukv": nrm((L, KV_RANK, N_HEADS * (QK_NOPE + V_DIM)), KV_RANK ** -0.5),
        "w_attn_proj": nrm((L, N_HEADS * V_DIM, D), (N_HEADS * V_DIM) ** -0.5),
        "w_out": nrm((L, D, D), D ** -0.5),
        "norm_ffn2": gain((L, D)),
        "w_ffn2_gate": nrm((L, D, D_FF), D ** -0.5),
        "w_ffn2_up": nrm((L, D, D_FF), D ** -0.5),
        "w_ffn2_down": nrm((L, D_FF, D), D_FF ** -0.5),
        "final_norm": gain((D,)),
    }


def reference(x_prompt, x_sample, cache_ckv, cache_krope, c, c_ctx, w_mod, b_mod, norm_ffn1, w_ffn1_gate,
              w_ffn1_up, w_ffn1_down, norm_mix, w_in, w_four, q_norm, w_uq, kv_norm, w_ukv, w_attn_proj,
              w_out, norm_ffn2, w_ffn2_gate, w_ffn2_up, w_ffn2_down, final_norm):
    tables = _axial_tables(x_sample.shape[1])
    xp, xs = x_prompt, x_sample
    ckvs, krs = [], []
    for l in range(DEPTH):
        p = {"norm_ffn1": norm_ffn1[l], "w_ffn1_gate": w_ffn1_gate[l], "w_ffn1_up": w_ffn1_up[l],
             "w_ffn1_down": w_ffn1_down[l], "norm_mix": norm_mix[l], "w_in": w_in[l], "w_four": w_four[l],
             "q_norm": q_norm[l], "w_uq": w_uq[l], "kv_norm": kv_norm[l], "w_ukv": w_ukv[l],
             "w_attn_proj": w_attn_proj[l], "w_out": w_out[l], "norm_ffn2": norm_ffn2[l],
             "w_ffn2_gate": w_ffn2_gate[l], "w_ffn2_up": w_ffn2_up[l], "w_ffn2_down": w_ffn2_down[l]}
        mod_ctx = (jax.nn.silu(c_ctx) @ w_mod[l] + b_mod[l])[None, None, :]
        mod_lat = (jax.nn.silu(c) @ w_mod[l] + b_mod[l])[:, None, :]
        xp, ckv_l, kr_l = _layer(xp, mod_ctx, p, None, None, None)
        ckvs.append(ckv_l)
        krs.append(kr_l)
        xs, _, _ = _layer(xs, mod_lat, p, tables, cache_ckv[:, l], cache_krope[:, l])
    y_prompt = _rmsnorm(xp, final_norm)
    y_sample = _rmsnorm(xs, final_norm)
    new_ckv = jnp.stack(ckvs, axis=1)
    new_krope = jnp.stack(krs, axis=1)
    return (y_prompt, y_sample, new_ckv, new_krope)
```

```cpp
#include <hip/hip_runtime.h>
#include <hip/hip_bf16.h>
#include <hip/hip_cooperative_groups.h>
#include <cstdio>
namespace cg = cooperative_groups;

typedef unsigned short u16;
using bf16x8 = __attribute__((ext_vector_type(8))) short;
using bf16x4 = __attribute__((ext_vector_type(4))) short;
using f32x4  = __attribute__((ext_vector_type(4))) float;
#define DEVI __device__ __forceinline__

constexpr int D = 1024, T = 8192, TCTX = 4096, FF = 2816, NKEY = 10240;
constexpr int NMODC = 9216;
constexpr float EPS = 1e-6f;

constexpr int LDH = 1088, LDW = 1088;
static_assert(LDH == LDW, "gemm8p shares the staging offsets between A and B");
constexpr size_t SZ_WGU = 5632ull * LDW * 2, SZ_WD = 1024ull * 2816 * 2, SZ_WIN = 3072ull * 1024 * 2;
constexpr size_t SZ_W4F = 1024ull * 512 * 2, SZ_WUQ = 768ull * 384 * 2, SZ_WUKV = 1024ull * 256 * 2;
constexpr size_t SZ_WAP = 1024ull * 512 * 2, SZ_WOUT = 1024ull * 1024 * 2;
constexpr size_t OFF_WGU = 0;
constexpr size_t OFF_WD = OFF_WGU + 4 * SZ_WGU;
constexpr size_t OFF_WIN = OFF_WD + 4 * SZ_WD;
constexpr size_t OFF_W4F = OFF_WIN + 2 * SZ_WIN;
constexpr size_t OFF_WUQ = OFF_W4F + 2 * SZ_W4F;
constexpr size_t OFF_WUKV = OFF_WUQ + 2 * SZ_WUQ;
constexpr size_t OFF_WAP = OFF_WUKV + 2 * SZ_WUKV;
constexpr size_t OFF_WOUT = OFF_WAP + 2 * SZ_WAP;
constexpr size_t OFF_CSLAT = OFF_WOUT + 2 * SZ_WOUT;
constexpr size_t OFF_CSCTX = OFF_CSLAT + 2048ull * 1024 * 2;
constexpr size_t OFF_ROPE = OFF_CSCTX + 512ull * 256 * 2;
constexpr size_t OFF_MODPART = OFF_ROPE + 1024ull * 32 * 4;
constexpr size_t OFF_MOD = OFF_MODPART + 2ull * 32 * 5 * 9216 * 4;
constexpr size_t OFF_X = OFF_MOD + 2ull * 5 * 9216 * 4;
constexpr size_t OFF_H = OFF_X + 8192ull * 1024 * 4;
constexpr size_t OFF_ACT = OFF_H + 8192ull * LDH * 2;
constexpr size_t OFF_QLAT = OFF_ACT;
constexpr size_t OFF_CKV = OFF_QLAT + 8192ull * 384 * 4;
constexpr size_t OFF_KROPE = OFF_CKV + 8192ull * 256 * 4;
constexpr size_t OFF_FINT = OFF_KROPE + 8192ull * 32 * 4;
constexpr size_t OFF_QN = OFF_FINT + 8192ull * 256 * 2;
constexpr size_t OFF_YCS = OFF_QN + 8192ull * 384 * 2;
constexpr size_t OFF_AMIX = OFF_QLAT;
constexpr size_t OFF_SGF = OFF_ACT + 8192ull * 2816 * 2;
constexpr size_t OFF_SGA = OFF_SGF + 8192ull * 1024 * 2;
constexpr size_t OFF_QF = OFF_SGA + 8192ull * 1024 * 2;
constexpr size_t OFF_KNOPE = OFF_QF + 8192ull * 768 * 2;
constexpr size_t OFF_VT = OFF_KNOPE + 10240ull * 512 * 2;
constexpr size_t OFF_O = OFF_VT + 10240ull * 512 * 2;
constexpr size_t OFF_KEYCKV = OFF_O + 8192ull * 512 * 2;
constexpr size_t OFF_KEYROPE = OFF_KEYCKV + 10240ull * 256 * 2;
constexpr size_t OFF_PQ = OFF_KEYROPE + 10240ull * 32 * 2;
constexpr size_t OFF_PK = OFF_PQ + 8192ull * 8 * 4;
constexpr size_t OFF_BAR = OFF_PK + 8192ull * 4 * 4;
constexpr size_t WS_TOTAL = OFF_BAR + 16384;
static_assert(OFF_YCS + 8192ull * 512 * 2 <= OFF_SGF, "act alias overflow");

struct Params {
  const float* in[26];
  float* out;
  char* ws;
};
DEVI int tidx() { int t = threadIdx.x; asm volatile("" : "+v"(t)); return t; }
DEVI char* wsp(const Params& p) {
  typedef __attribute__((address_space(1))) char gchar;
  gchar* w = (gchar*)p.ws;
  asm volatile("" : "+s"(w));
  return (char*)w;
}
#define PWS (wsp(p))


DEVI unsigned pk2(float a, float b) {
  typedef __attribute__((ext_vector_type(2))) __bf16 bf2;
  typedef __attribute__((ext_vector_type(2))) float f2;
  f2 v = {a, b};
  bf2 r = __builtin_convertvector(v, bf2);
  return *(unsigned*)&r;
}
DEVI u16 f2bf(float a) { return (u16)(pk2(a, 0.f) & 0xffff); }
DEVI float bf2f(u16 h) { return __uint_as_float(((unsigned)h) << 16); }
DEVI void st_bf4(u16* dst, float a, float b, float c, float d) {
  uint2 v; v.x = pk2(a, b); v.y = pk2(c, d);
  *(uint2*)dst = v;
}
DEVI float shx(float v, int mask, int lane) {
  return __int_as_float(__builtin_amdgcn_ds_bpermute((lane ^ mask) << 2, __float_as_int(v)));
}
DEVI float4 ld_nt4(const float* p) {
  typedef float v4f __attribute__((ext_vector_type(4)));
  const v4f v = __builtin_nontemporal_load((const v4f*)p);
  return float4{v[0], v[1], v[2], v[3]};
}
DEVI float wave_sum(float v, int lane) {
#pragma unroll
  for (int o = 32; o > 0; o >>= 1) v += shx(v, o, lane);
  return v;
}
DEVI float siluf(float x) { return x * __builtin_amdgcn_rcpf(1.f + __expf(-x)); }
DEVI float sigmf(float x) { return __builtin_amdgcn_rcpf(1.f + __expf(-x)); }
DEVI int mod_row(int t) { return t < TCTX ? 0 : 1 + ((t - TCTX) >> 10); }

constexpr int NT = 512, NWV = 8;
constexpr int TM = 256, TN = 128, BK = 64;
constexpr int ROWB = BK * 2;
constexpr int A_TILE_B = TM * ROWB;
constexpr int B_TILE_B = TN * ROWB;
constexpr int STAGE_B = A_TILE_B + B_TILE_B;
constexpr int NSTAGE = 3;
constexpr int LDS_BYTES = NSTAGE * STAGE_B;
constexpr int KS = BK / 32;

DEVI void glds16(const void* g, void* l) {
  __builtin_amdgcn_global_load_lds((const unsigned*)g, (unsigned*)l, 16, 0, 0);
}

DEVI void zero_acc(f32x4 (&acc)[4][4]) {
#pragma unroll
  for (int m = 0; m < 4; ++m)
#pragma unroll
    for (int n = 0; n < 4; ++n) acc[m][n] = f32x4{0.f, 0.f, 0.f, 0.f};
}

DEVI bool tile_xcd(int idx, int nM, int nN, int& tm, int& tn) {
  const int x = idx & 7, s = idx >> 3;
  const int SN = (nN & 3) == 0 ? 4 : 2, per = 8 * SN;
  const int k = s / per, w = s % per;
  const int st = k * 8 + x, nsm = nM >> 3;
  const int sm = st % nsm, sn = st / nsm;
  tm = sm * 8 + (w & 7);
  tn = sn * SN + (w >> 3);
  return sn * SN < nN;
}
DEVI void tile_mn(int idx, int nM, int nN, int& tm, int& tn) {
  const int nig = 8 * nN, gid = idx / nig, fm = gid * 8, gsz = min(nM - fm, 8), r = idx % nig;
  tm = fm + (r % gsz);
  tn = r / gsz;
}


struct TileDesc { const u16* A; const u16* B; int lda, ldb, nt; };
DEVI void touch_frags(const bf16x8 (&a)[4], const bf16x8 (&b)[4]) {
  asm volatile("" ::"v"(a[0]), "v"(a[1]), "v"(a[2]), "v"(a[3]), "v"(b[0]), "v"(b[1]), "v"(b[2]), "v"(b[3]));
}

template <class GetTile, class Epi>
DEVI void gemm_stream(int ntiles, GetTile get_tile, Epi epi, char* smem) {
  const int tid = tidx(), wid = tid >> 6, lane = tid & 63, wr = wid >> 1, wc = wid & 1, fr = lane & 15, fq = lane >> 4;
  int nloc = 0;
  while ((int)blockIdx.x + nloc * (int)gridDim.x < ntiles && get_tile((int)blockIdx.x + nloc * (int)gridDim.x).nt > 0) ++nloc;
  if (nloc <= 0) return;
  const int srow = tid >> 3, schunk8 = ((tid & 7) ^ ((tid >> 4) & 7)) * 8;
  int it = 0, ikt = 0, ibuf = 0;
  TileDesc id = get_tile((int)blockIdx.x);
  const u16* ga = id.A + (size_t)srow * id.lda + schunk8;
  const u16* gb = id.B + (size_t)srow * id.ldb + schunk8;
  auto issue = [&]() -> bool {
    if (it >= nloc) return false;
    char* sa = smem + ibuf * STAGE_B + tid * 16;
    char* sb = sa + A_TILE_B;
#pragma unroll
    for (int i = 0; i < 4; ++i) glds16(ga + (size_t)(i * 64) * id.lda + ikt * BK, sa + i * 8192);
#pragma unroll
    for (int i = 0; i < 2; ++i) glds16(gb + (size_t)(i * 64) * id.ldb + ikt * BK, sb + i * 8192);
    ibuf = ibuf == 2 ? 0 : ibuf + 1;
    if (++ikt == id.nt) {
      ikt = 0; ++it;
      if (it < nloc) {
        id = get_tile((int)blockIdx.x + it * (int)gridDim.x);
        ga = id.A + (size_t)srow * id.lda + schunk8;
        gb = id.B + (size_t)srow * id.ldb + schunk8;
      }
    }
    return true;
  };
  const int fswz = fr >> 1;
  const int aoff = (wr * 64 + fr) * ROWB, boff = A_TILE_B + (wc * 64 + fr) * ROWB;
  const int p0 = (fq ^ fswz) * 16, p1 = ((4 + fq) ^ fswz) * 16;
  bf16x8 a0[4], b0[4], a1[4], b1[4];
  asm volatile("s_waitcnt vmcnt(0)" ::: "memory");
  issue();
  if (issue()) asm volatile("s_waitcnt vmcnt(6)" ::: "memory");
  else         asm volatile("s_waitcnt vmcnt(0)" ::: "memory");
  __builtin_amdgcn_s_barrier();
  asm volatile("" ::: "memory");
  int cbuf = 0;
#pragma unroll
  for (int m = 0; m < 4; ++m) a0[m] = *(const bf16x8*)(smem + aoff + m * 16 * ROWB + p0);
#pragma unroll
  for (int n = 0; n < 4; ++n) b0[n] = *(const bf16x8*)(smem + boff + n * 16 * ROWB + p0);
  touch_frags(a0, b0);
  for (int t = 0; t < nloc; ++t) {
    const int nt = get_tile((int)blockIdx.x + t * (int)gridDim.x).nt;
    f32x4 acc[4][4];
#pragma unroll
    for (int m = 0; m < 4; ++m)
#pragma unroll
      for (int n = 0; n < 4; ++n) acc[m][n] = f32x4{0.f, 0.f, 0.f, 0.f};
    for (int kt = 0; kt < nt; ++kt) {
      const bool issued = issue();
      const char* sb_ = smem + cbuf * STAGE_B;
#pragma unroll
      for (int m = 0; m < 4; ++m) a1[m] = *(const bf16x8*)(sb_ + aoff + m * 16 * ROWB + p1);
#pragma unroll
      for (int n = 0; n < 4; ++n) b1[n] = *(const bf16x8*)(sb_ + boff + n * 16 * ROWB + p1);
      __builtin_amdgcn_sched_barrier(0);
      __builtin_amdgcn_s_setprio(1);
#pragma unroll
      for (int m = 0; m < 4; ++m)
#pragma unroll
        for (int n = 0; n < 4; ++n) acc[m][n] = __builtin_amdgcn_mfma_f32_16x16x32_bf16(b0[n], a0[m], acc[m][n], 0, 0, 0);
      __builtin_amdgcn_s_setprio(0);
      __builtin_amdgcn_sched_barrier(0);
      touch_frags(a1, b1);
      asm volatile("s_waitcnt lgkmcnt(0)" ::: "memory");
      if (issued) asm volatile("s_waitcnt vmcnt(6)" ::: "memory");
      else        asm volatile("s_waitcnt vmcnt(0)" ::: "memory");
      __builtin_amdgcn_s_barrier();
      asm volatile("" ::: "memory");
      cbuf = cbuf == 2 ? 0 : cbuf + 1;
      if (kt + 1 < nt || t + 1 < nloc) {
        const char* sn = smem + cbuf * STAGE_B;
#pragma unroll
        for (int m = 0; m < 4; ++m) a0[m] = *(const bf16x8*)(sn + aoff + m * 16 * ROWB + p0);
#pragma unroll
        for (int n = 0; n < 4; ++n) b0[n] = *(const bf16x8*)(sn + boff + n * 16 * ROWB + p0);
      }
      __builtin_amdgcn_sched_barrier(0);
      __builtin_amdgcn_s_setprio(1);
#pragma unroll
      for (int m = 0; m < 4; ++m)
#pragma unroll
        for (int n = 0; n < 4; ++n) acc[m][n] = __builtin_amdgcn_mfma_f32_16x16x32_bf16(b1[n], a1[m], acc[m][n], 0, 0, 0);
      __builtin_amdgcn_s_setprio(0);
      __builtin_amdgcn_sched_barrier(0);
      touch_frags(a0, b0);
    }
    epi((int)blockIdx.x + t * (int)gridDim.x, acc);
  }
}


constexpr int P8_HT = 128 * 64;
DEVI int p8_lds_byte(int r, int c) {
  const int st = (r >> 4) * 2 + (c >> 5), rr = r & 15, cc = c & 31, ob = rr * 64 + cc * 2;
  return st * 1024 + (ob ^ (((ob >> 9) & 1) << 5));
}
DEVI void p8_stage_rc(int b, int& R, int& C) {
  const int st = b / 1024, sb = b % 1024, swz = sb ^ (((sb >> 9) & 1) << 5);
  R = (st >> 1) * 16 + swz / 64;
  C = (st & 1) * 32 + (swz % 64) / 2;
}
DEVI void gemm8p_tile(f32x4 (&acc)[2][2][4][2], const u16* __restrict__ A, int lda, const u16* __restrict__ Bt, int ldb, int K,
                      char* smem, bool primed) {
  u16* shm = (u16*)smem;
  const int tid = tidx();
  const int wid = tid >> 6, lane = tid & 63, wr = wid >> 2, wc = wid & 3, fr = lane & 15, fq = lane >> 4;
#define P8_SA(b, h) (shm + ((b) * 2 + (h)) * P8_HT)
#define P8_SB(b, h) (shm + (4 + (b) * 2 + (h)) * P8_HT)
  int sr0, sc0, sr1, sc1;
  p8_stage_rc(tid * 16, sr0, sc0);
  p8_stage_rc(tid * 16 + 8192, sr1, sc1);
  const unsigned oa0 = (unsigned)(sr0 * lda + sc0) * 2u, oa1 = (unsigned)(sr1 * lda + sc1) * 2u;
#define P8_STAGE_A(P, BASE, br, kt) do { const char* _g = (const char*)((BASE) + (size_t)(br) * lda + (kt) * 64); \
    glds16(_g + oa0, (char*)(P) + tid * 16); glds16(_g + oa1, (char*)(P) + tid * 16 + 8192); } while (0)
#define P8_STAGE_B(P, BASE, br, kt) do { const char* _g = (const char*)((BASE) + (size_t)(br) * ldb + (kt) * 64); \
    glds16(_g + oa0, (char*)(P) + tid * 16); glds16(_g + oa1, (char*)(P) + tid * 16 + 8192); } while (0)
#define P8_LDA(dst, b, h) for (int m = 0; m < 4; ++m) for (int k = 0; k < 2; ++k) \
    dst[m][k] = *reinterpret_cast<const bf16x8*>((char*)P8_SA(b, h) + p8_lds_byte(wr * 64 + m * 16 + fr, k * 32 + fq * 8))
#define P8_LDB(dst, b, h) for (int n = 0; n < 2; ++n) for (int k = 0; k < 2; ++k) \
    dst[n][k] = *reinterpret_cast<const bf16x8*>((char*)P8_SB(b, h) + p8_lds_byte(wc * 32 + n * 16 + fr, k * 32 + fq * 8))
#define P8_MMA(ai, bj, At_, Bt_) do { __builtin_amdgcn_s_setprio(1); \
    for (int m = 0; m < 4; ++m) for (int n = 0; n < 2; ++n) for (int k = 0; k < 2; ++k) \
      acc[ai][bj][m][n] = __builtin_amdgcn_mfma_f32_16x16x32_bf16(Bt_[n][k], At_[m][k], acc[ai][bj][m][n], 0, 0, 0); \
    __builtin_amdgcn_s_setprio(0); } while (0)
#define P8_WAIT_V(n) asm volatile("s_waitcnt vmcnt(" #n ")" ::: "memory")
#define P8_WAIT_L(n) asm volatile("s_waitcnt lgkmcnt(" #n ")" ::: "memory")
#define P8_BAR __builtin_amdgcn_s_barrier()
#define P8_SCHED __builtin_amdgcn_sched_barrier(0)
  bf16x8 At[4][2], B0[2][2], B1[2][2];
  const int nt = K / 64;
  if (!primed) {
    P8_WAIT_V(0);
    P8_STAGE_B(P8_SB(0, 0), Bt, 0, 0); P8_STAGE_A(P8_SA(0, 0), A, 0, 0);
    P8_STAGE_B(P8_SB(0, 1), Bt, 128, 0); P8_STAGE_A(P8_SA(0, 1), A, 128, 0);
  }
  if (wr == 1) P8_BAR;
  P8_WAIT_V(4); P8_BAR;
  P8_STAGE_B(P8_SB(1, 0), Bt, 0, 1); P8_STAGE_A(P8_SA(1, 0), A, 0, 1); P8_STAGE_B(P8_SB(1, 1), Bt, 128, 1);
  P8_WAIT_V(6); P8_BAR;
  for (int t = 0; t < nt - 2; t += 2) {
    P8_LDB(B0, 0, 0); P8_SCHED; P8_LDA(At, 0, 0); P8_STAGE_A(P8_SA(1, 1), A, 128, t + 1);
    P8_WAIT_L(8); P8_BAR; P8_WAIT_L(0); P8_MMA(0, 0, At, B0); P8_BAR; P8_SCHED;
    P8_LDB(B1, 0, 1); P8_STAGE_B(P8_SB(0, 0), Bt, 0, t + 2);
    P8_BAR; P8_WAIT_L(0); P8_MMA(0, 1, At, B1); P8_BAR;
    P8_LDA(At, 0, 1); P8_STAGE_A(P8_SA(0, 0), A, 0, t + 2);
    P8_BAR; P8_WAIT_L(0); P8_MMA(1, 0, At, B0); P8_BAR; P8_SCHED;
    P8_STAGE_B(P8_SB(0, 1), Bt, 128, t + 2);
    P8_WAIT_V(6); P8_BAR; P8_MMA(1, 1, At, B1); P8_BAR;
    P8_LDB(B0, 1, 0); P8_SCHED; P8_LDA(At, 1, 0); P8_STAGE_A(P8_SA(0, 1), A, 128, t + 2);
    P8_WAIT_L(8); P8_BAR; P8_WAIT_L(0); P8_MMA(0, 0, At, B0); P8_BAR; P8_SCHED;
    P8_LDB(B1, 1, 1); P8_STAGE_B(P8_SB(1, 0), Bt, 0, t + 3);
    P8_BAR; P8_WAIT_L(0); P8_MMA(0, 1, At, B1); P8_BAR;
    P8_LDA(At, 1, 1); P8_STAGE_A(P8_SA(1, 0), A, 0, t + 3);
    P8_BAR; P8_WAIT_L(0); P8_MMA(1, 0, At, B0); P8_BAR; P8_SCHED;
    P8_STAGE_B(P8_SB(1, 1), Bt, 128, t + 3);
    P8_WAIT_V(6); P8_BAR; P8_MMA(1, 1, At, B1); P8_BAR;
  }
  { P8_LDB(B0, 0, 0); P8_LDA(At, 0, 0); P8_STAGE_A(P8_SA(1, 1), A, 128, nt - 1);
    P8_BAR; P8_WAIT_L(0); P8_MMA(0, 0, At, B0); P8_BAR;
    P8_LDB(B1, 0, 1); P8_BAR; P8_WAIT_L(0); P8_MMA(0, 1, At, B1); P8_BAR;
    P8_LDA(At, 0, 1); P8_WAIT_V(4); P8_BAR; P8_WAIT_L(0); P8_MMA(1, 0, At, B0); P8_MMA(1, 1, At, B1); P8_BAR; }
  { P8_LDB(B0, 1, 0); P8_LDA(At, 1, 0); P8_WAIT_V(2); P8_BAR; P8_WAIT_L(0); P8_MMA(0, 0, At, B0); P8_BAR;
    P8_LDB(B1, 1, 1); P8_WAIT_V(0); P8_BAR; P8_WAIT_L(0); P8_MMA(0, 1, At, B1); P8_BAR;
    P8_LDA(At, 1, 1); P8_BAR; P8_WAIT_L(0); P8_MMA(1, 0, At, B0); P8_MMA(1, 1, At, B1); P8_BAR; }
  if (wr == 0) P8_BAR;
}
DEVI void gemm8p_prime(const u16* __restrict__ A, int lda, const u16* __restrict__ Bt, int ldb, char* smem) {
  u16* shm = (u16*)smem;
  const int tid = tidx();
  int sr0, sc0, sr1, sc1;
  p8_stage_rc(tid * 16, sr0, sc0);
  p8_stage_rc(tid * 16 + 8192, sr1, sc1);
  const unsigned oa0 = (unsigned)(sr0 * lda + sc0) * 2u, oa1 = (unsigned)(sr1 * lda + sc1) * 2u;
  P8_STAGE_B(P8_SB(0, 0), Bt, 0, 0); P8_STAGE_A(P8_SA(0, 0), A, 0, 0);
  P8_STAGE_B(P8_SB(0, 1), Bt, 128, 0); P8_STAGE_A(P8_SA(0, 1), A, 128, 0);
}

DEVI int dst_row(int kind, int c) {
  if (kind == 0) return c;
  if (kind == 1) return 32 * (c >> 4) + (c & 15);
  if (kind == 2) return 32 * (c >> 4) + 16 + (c & 15);
  if (kind == 3) return c < 928 ? c : (c < 1952 ? 1024 + (c - 928) : 2048 + (c - 1952));
  const int h = c >> 7, r = c & 127;
  return r < 64 ? h * 64 + r : 512 + h * 64 + (r - 64);
}
DEVI void transpose_tile(const float* __restrict__ src, int Nsrc, int ldd, int k0, int c0, int ncol, u16* __restrict__ dst, int kind,
                         char* smem) {
  float* sm = (float*)smem;
  const int tid = tidx();
  float4 v[8];
#pragma unroll
  for (int ps = 0; ps < 8; ++ps) {
    const int q = tid + ps * 512;
    const int cc = ((q & 7) + 8 * ((q >> 5) & 3)) * 4, r = (q >> 7) * 4 + ((q >> 3) & 3);
    v[ps] = ld_nt4(src + (size_t)(k0 + r) * Nsrc + c0 + min(cc, ncol - 4));
  }
#pragma unroll
  for (int ps = 0; ps < 8; ++ps) {
    const int q = tid + ps * 512;
    const int cc = ((q & 7) + 8 * ((q >> 5) & 3)) * 4, r = (q >> 7) * 4 + ((q >> 3) & 3);
    sm[r * 129 + cc + 0] = v[ps].x; sm[r * 129 + cc + 1] = v[ps].y; sm[r * 129 + cc + 2] = v[ps].z; sm[r * 129 + cc + 3] = v[ps].w;
  }
  __syncthreads();
#pragma unroll
  for (int ps = 0; ps < 4; ++ps) {
    const int q = tid + ps * 512;
    const int kk = ((q & 3) + 4 * ((q >> 5) & 3)) * 8, rr = (q >> 7) * 8 + ((q >> 2) & 7);
    if (rr < ncol) {
      uint4 o;
      o.x = pk2(sm[(kk + 0) * 129 + rr], sm[(kk + 1) * 129 + rr]);
      o.y = pk2(sm[(kk + 2) * 129 + rr], sm[(kk + 3) * 129 + rr]);
      o.z = pk2(sm[(kk + 4) * 129 + rr], sm[(kk + 5) * 129 + rr]);
      o.w = pk2(sm[(kk + 6) * 129 + rr], sm[(kk + 7) * 129 + rr]);
      {
        typedef unsigned v4u_t __attribute__((ext_vector_type(4)));
        v4u_t ov = {o.x, o.y, o.z, o.w};
        __builtin_nontemporal_store(ov, (v4u_t*)(dst + (size_t)dst_row(kind, c0 + rr) * ldd + k0 + kk));
      }
    }
  }
  __syncthreads();
}

constexpr int PREP_PER_LAYER = 176 * 6 + 192 + 18 + 16 + 32 + 64;
DEVI void prep_convert_task(const Params& p, char* ws, int task, char* smem) {
  constexpr int PER_LAYER = PREP_PER_LAYER;
    const int l = task / PER_LAYER;
    int r = task % PER_LAYER;
    const float* src; int K, Nsrc; u16* dst; int kind;
    if (r < 176 * 6) {
      const int which = r / 176; r %= 176;
      const int f = which / 3, w = which % 3;
      const int inidx = (f == 0 ? 9 : 22) + w;
      if (w < 2) { K = 1024; Nsrc = FF; src = p.in[inidx] + (size_t)l * 1024 * FF; dst = (u16*)(ws + OFF_WGU + (l * 2 + f) * SZ_WGU); kind = 1 + w; }
      else       { K = FF; Nsrc = 1024; src = p.in[inidx] + (size_t)l * 1024 * FF; dst = (u16*)(ws + OFF_WD + (l * 2 + f) * SZ_WD); kind = 0; }
    } else {
      r -= 176 * 6;
      if (r < 192) { K = 1024; Nsrc = 2976; src = p.in[13] + (size_t)l * 1024 * 2976; dst = (u16*)(ws + OFF_WIN + l * SZ_WIN); kind = 3; }
      else if ((r -= 192) < 18) { K = 384; Nsrc = 768; src = p.in[16] + (size_t)l * 384 * 768; dst = (u16*)(ws + OFF_WUQ + l * SZ_WUQ); kind = 0; }
      else if ((r -= 18) < 16) { K = 256; Nsrc = 1024; src = p.in[18] + (size_t)l * 256 * 1024; dst = (u16*)(ws + OFF_WUKV + l * SZ_WUKV); kind = 4; }
      else if ((r -= 16) < 32) { K = 512; Nsrc = 1024; src = p.in[19] + (size_t)l * 512 * 1024; dst = (u16*)(ws + OFF_WAP + l * SZ_WAP); kind = 0; }
      else { r -= 32; K = 1024; Nsrc = 1024; src = p.in[20] + (size_t)l * 1024 * 1024; dst = (u16*)(ws + OFF_WOUT + l * SZ_WOUT); kind = 0; }
    }
    const int nkt = K / 128;
    const int ct = r / nkt, kt = r % nkt;
    const int c0 = ct * 128;
    const int ncol = min(128, Nsrc - c0);
    transpose_tile(src, Nsrc, (kind == 1 || kind == 2) ? LDW : K, kt * 128, c0, ncol, dst, kind, smem);
}

DEVI void phase_prep(const Params& p, char* smem) {
  const int tid = tidx();
  char* ws = PWS;
  {
    const int ntask = gridDim.x == 256 ? PREP_PER_LAYER : 2 * PREP_PER_LAYER;
    for (int task = blockIdx.x; task < ntask; task += gridDim.x) prep_convert_task(p, ws, task, smem);
  }
  for (int i = blockIdx.x * NT + tid; i < 2 * 96 * 1024 / 8; i += gridDim.x * NT) {
    const int l = i / (96 * 128), e = i % (96 * 128);
    unsigned z = 0; asm volatile("" : "+v"(z));
    *(uint4*)(ws + OFF_WIN + l * SZ_WIN + (size_t)928 * 1024 * 2 + (size_t)e * 16) = uint4{z, z, z, z};
  }
  {
    float* sc = (float*)smem;
    float* part = sc + 5 * 1024;
    __syncthreads();
    for (int i = tid; i < 5 * 1024; i += NT) {
      const int rr = i >> 10, k = i & 1023;
      sc[i] = siluf(rr == 0 ? p.in[5][k] : p.in[4][(rr - 1) * 1024 + k]);
    }
    __syncthreads();
    const int wid = tid >> 6, lane = tid & 63, half = lane >> 5, q = min(lane & 31, 17);
    for (int task = blockIdx.x; task < 256; task += gridDim.x) {
      const int l = task >> 7, c0 = (task & 127) * 72;
      const float* w = p.in[6] + (size_t)l * 1024 * NMODC + (size_t)(wid * 128 + half) * NMODC + c0 + q * 4;
      float4 a0 = {0, 0, 0, 0}, a1 = a0, a2 = a0, a3 = a0, a4 = a0;
#pragma unroll 1
      for (int ib = 0; ib < 4; ++ib) {
        float4 wv[16];
#pragma unroll
        for (int j = 0; j < 16; ++j) wv[j] = ld_nt4(w + (size_t)(2 * (ib * 16 + j)) * NMODC);
        __builtin_amdgcn_sched_barrier(0);
#pragma unroll
        for (int j = 0; j < 16; ++j) {
          const int k = wid * 128 + 2 * (ib * 16 + j) + half;
          const float s0 = sc[k], s1 = sc[1024 + k], s2 = sc[2048 + k], s3 = sc[3072 + k], s4 = sc[4096 + k];
          a0.x += s0 * wv[j].x; a0.y += s0 * wv[j].y; a0.z += s0 * wv[j].z; a0.w += s0 * wv[j].w;
          a1.x += s1 * wv[j].x; a1.y += s1 * wv[j].y; a1.z += s1 * wv[j].z; a1.w += s1 * wv[j].w;
          a2.x += s2 * wv[j].x; a2.y += s2 * wv[j].y; a2.z += s2 * wv[j].z; a2.w += s2 * wv[j].w;
          a3.x += s3 * wv[j].x; a3.y += s3 * wv[j].y; a3.z += s3 * wv[j].z; a3.w += s3 * wv[j].w;
          a4.x += s4 * wv[j].x; a4.y += s4 * wv[j].y; a4.z += s4 * wv[j].z; a4.w += s4 * wv[j].w;
        }
        __builtin_amdgcn_sched_barrier(0);
      }
#define MOD_RED(A) A.x += shx(A.x, 32, lane); A.y += shx(A.y, 32, lane); A.z += shx(A.z, 32, lane); A.w += shx(A.w, 32, lane);
      MOD_RED(a0) MOD_RED(a1) MOD_RED(a2) MOD_RED(a3) MOD_RED(a4)
#undef MOD_RED
      if (lane < 18) {
        float* pp = part + wid * 360 + lane * 4;
        *(float4*)(pp) = a0; *(float4*)(pp + 72) = a1; *(float4*)(pp + 144) = a2; *(float4*)(pp + 216) = a3; *(float4*)(pp + 288) = a4;
      }
      __syncthreads();
      if (tid < 360) {
        const int rr = tid / 72, c = c0 + tid % 72;
        float s = p.in[7][l * NMODC + c];
#pragma unroll
        for (int w8 = 0; w8 < 8; ++w8) s += part[w8 * 360 + tid];
        ((float*)(ws + OFF_MOD))[(size_t)(l * 5 + rr) * NMODC + c] = s;
      }
      __syncthreads();
    }
  }
  {
    u16* cl = (u16*)(ws + OFF_CSLAT);
    for (int i = blockIdx.x * NT + tid; i < 2048 * 1024; i += gridDim.x * NT) {
      const int r = i >> 10, n = i & 1023;
      const int m = ((r & 1023) * n) & 1023;
      const float a = (float)m * (1.f / 512.f);
      cl[i] = f2bf(r < 1024 ? cospif(a) : sinpif(a));
    }
    u16* cc = (u16*)(ws + OFF_CSCTX);
    for (int i = blockIdx.x * NT + tid; i < 512 * 256; i += gridDim.x * NT) {
      const int r = i >> 8, n = i & 255;
      const int m = ((r & 255) * n) & 255;
      const float a = (float)m * (1.f / 128.f);
      cc[i] = f2bf(r < 256 ? cospif(a) : sinpif(a));
    }
    float* rt = (float*)(ws + OFF_ROPE);
    for (int i = blockIdx.x * NT + tid; i < 1024 * 16; i += gridDim.x * NT) {
      const int pos = i >> 4, a = (i >> 3) & 1, f = i & 7;
      const float inv = powf(10000.0f, -(float)(2 * f) / 16.0f);
      const float ang = (float)(a == 0 ? (pos >> 6) : (pos & 63)) * inv;
      rt[pos * 32 + a * 8 + f] = cosf(ang);
      rt[pos * 32 + 16 + a * 8 + f] = sinf(ang);
    }
  }
  {
    float* tb = (float*)smem;
    float* w4s = tb + 128;
    __syncthreads();
    if (tid < 64) { tb[tid] = cospif((float)tid * (1.f / 32.f)); tb[64 + tid] = sinpif((float)tid * (1.f / 32.f)); }
    for (int task = blockIdx.x; task < 256; task += gridDim.x) {
      const int l = task >> 7, g = (task >> 5) & 3, j0 = (task & 31) * 32;
      __syncthreads();
      for (int i = tid; i < 2048; i += NT) w4s[i] = p.in[14][(size_t)l * 256 * 1024 + (size_t)(g * 64 + (i >> 5)) * 1024 + j0 + (i & 31)];
      __syncthreads();
      const int j = tid & 31, kq = tid >> 5;
      u16* o = (u16*)(ws + OFF_W4F + l * SZ_W4F) + (size_t)(j0 + j) * 512 + g * 64 + kq * 4;
#pragma unroll 1
      for (int cs = 0; cs < 2; ++cs) {
        float a[4];
#pragma unroll
        for (int kk = 0; kk < 4; ++kk) a[kk] = 0.f;
#pragma unroll 4
        for (int k2 = 0; k2 < 64; ++k2) {
          const float wv = w4s[k2 * 32 + j];
#pragma unroll
          for (int kk = 0; kk < 4; ++kk) a[kk] += tb[cs * 64 + (((kq * 4 + kk) * k2) & 63)] * wv;
        }
        const float sg = cs ? -1.f : 1.f;
        uint2 ov;
        ov.x = pk2(sg * a[0], sg * a[1]); ov.y = pk2(sg * a[2], sg * a[3]);
        *(uint2*)(o + cs * 256) = ov;
      }
    }
    __syncthreads();
  }
}

DEVI const float* x_row(const Params& p, bool from_input, int t) {
  if (from_input) return t < TCTX ? p.in[0] + (size_t)t * D : p.in[1] + (size_t)(t - TCTX) * D;
  return (const float*)(PWS + OFF_X) + (size_t)t * D;
}

DEVI void phase_norm(const Params& p, int l, int which, bool from_input) {
  const int lane = tidx() & 63, gw = blockIdx.x * NWV + (tidx() >> 6), nw = gridDim.x * NWV;
  const float* gain = p.in[which == 0 ? 8 : (which == 1 ? 12 : 21)] + l * D;
  const float* mod = (const float*)(PWS + OFF_MOD) + (size_t)l * 5 * NMODC;
  u16* h = (u16*)(PWS + OFF_H);
  for (int t = gw; t < T; t += nw) {
    const float* xr = x_row(p, from_input, t);
    const float* m = mod + (size_t)mod_row(t) * NMODC + which * 3 * D;
    float4 v[4];
    float ss = 0.f;
#pragma unroll
    for (int i = 0; i < 4; ++i) {
      v[i] = *(const float4*)(xr + i * 256 + lane * 4);
      ss += v[i].x * v[i].x + v[i].y * v[i].y + v[i].z * v[i].z + v[i].w * v[i].w;
    }
    ss = wave_sum(ss, lane);
    const float rs = rsqrtf(ss * (1.f / D) + EPS);
#pragma unroll
    for (int i = 0; i < 4; ++i) {
      const int c = i * 256 + lane * 4;
      const float4 g = *(const float4*)(gain + c), sh = *(const float4*)(m + c), sc = *(const float4*)(m + D + c);
      st_bf4(h + (size_t)t * LDH + c, v[i].x * rs * g.x * (1.f + sc.x) + sh.x, v[i].y * rs * g.y * (1.f + sc.y) + sh.y,
             v[i].z * rs * g.z * (1.f + sc.z) + sh.z, v[i].w * rs * g.w * (1.f + sc.w) + sh.w);
    }
  }
}

DEVI void phase_cachecopy(const Params& p, int l) {
  const int lane = tidx() & 63, gw = blockIdx.x * NWV + (tidx() >> 6), nw = gridDim.x * NWV;
  u16* kc = (u16*)(PWS + OFF_KEYCKV);
  u16* kr = (u16*)(PWS + OFF_KEYROPE);
  for (int j = gw; j < 2048; j += nw) {
    const int b = j >> 9, n = j & 511;
    const int keyrow = TCTX + b * 1536 + 1024 + n;
    const float4 cv = *(const float4*)(p.in[2] + ((size_t)(b * 2 + l) * 512 + n) * 256 + lane * 4);
    st_bf4(kc + (size_t)keyrow * 256 + lane * 4, cv.x, cv.y, cv.z, cv.w);
    if (lane < 32) kr[(size_t)keyrow * 32 + lane] = f2bf(p.in[3][((size_t)(b * 2 + l) * 512 + n) * 32 + lane]);
  }
}

DEVI void phase_final(const Params& p) {
  const int lane = tidx() & 63, gw = blockIdx.x * NWV + (tidx() >> 6), nw = gridDim.x * NWV;
  const float* gain = p.in[25];
  for (int t = gw; t < T; t += nw) {
    const float* xr = (const float*)(PWS + OFF_X) + (size_t)t * D;
    float4 v[4];
    float ss = 0.f;
#pragma unroll
    for (int i = 0; i < 4; ++i) {
      v[i] = *(const float4*)(xr + i * 256 + lane * 4);
      ss += v[i].x * v[i].x + v[i].y * v[i].y + v[i].z * v[i].z + v[i].w * v[i].w;
    }
    ss = wave_sum(ss, lane);
    const float rs = rsqrtf(ss * (1.f / D) + EPS);
#pragma unroll
    for (int i = 0; i < 4; ++i) {
      const int c = i * 256 + lane * 4;
      const float4 g = *(const float4*)(gain + c);
      float4 o = {v[i].x * rs * g.x, v[i].y * rs * g.y, v[i].z * rs * g.z, v[i].w * rs * g.w};
      *(float4*)(p.out + (size_t)t * D + c) = o;
    }
  }
}

DEVI void phase_gu(const Params& p, int l, int f, char* smem) {
  char* ws = PWS;
  const u16* A = (const u16*)(ws + OFF_H);
  const u16* W = (const u16*)(ws + OFF_WGU + (l * 2 + f) * SZ_WGU);
  u16* act = (u16*)(ws + OFF_ACT);
  constexpr int nM = 32, nN = 22;
  for (int tile = blockIdx.x; tile < nM * nN; tile += gridDim.x) {
    int tm, tn; tile_mn(tile, nM, nN, tm, tn);
    f32x4 acc[2][2][4][2];
#pragma unroll
    for (int ai = 0; ai < 2; ++ai)
#pragma unroll
      for (int bj = 0; bj < 2; ++bj)
#pragma unroll
        for (int m = 0; m < 4; ++m)
#pragma unroll
          for (int n = 0; n < 2; ++n) acc[ai][bj][m][n] = f32x4{0.f, 0.f, 0.f, 0.f};
    gemm8p_tile(acc, A + (size_t)tm * 256 * LDH, LDH, W + (size_t)tn * 256 * LDW, LDW, D, smem, tile != (int)blockIdx.x);
    {
      const int nxt = tile + gridDim.x;
      if (nxt < nM * nN) { int tm2, tn2; tile_mn(nxt, nM, nN, tm2, tn2); gemm8p_prime(A + (size_t)tm2 * 256 * LDH, LDH, W + (size_t)tn2 * 256 * LDW, LDW, smem); }
    }
    const int tid2 = tidx(), wid = tid2 >> 6, lane = tid2 & 63, wr = wid >> 2, wc = wid & 3, fr = lane & 15, fq = lane >> 4;
#pragma unroll
    for (int ai = 0; ai < 2; ++ai)
#pragma unroll
      for (int m = 0; m < 4; ++m) {
        const int row = tm * 256 + ai * 128 + wr * 64 + m * 16 + fr;
#pragma unroll
        for (int bj = 0; bj < 2; ++bj) {
          const int ffc = (tn * 256 + bj * 128 + wc * 32) / 2 + fq * 4;
          const f32x4 g = acc[ai][bj][m][0], u = acc[ai][bj][m][1];
          st_bf4(act + (size_t)row * FF + ffc, siluf(g[0]) * u[0], siluf(g[1]) * u[1], siluf(g[2]) * u[2], siluf(g[3]) * u[3]);
        }
      }
  }
  if (l == 0 && gridDim.x == 256 && blockIdx.x >= 192) {
    __syncthreads();
    const int first = PREP_PER_LAYER + (f == 0 ? 0 : 704), count = f == 0 ? 704 : PREP_PER_LAYER - 704;
    for (int t = blockIdx.x - 192; t < count; t += 64) prep_convert_task(p, ws, first + t, smem);
  }
}

DEVI void phase_resid(const Params& p, const u16* A, int lda, int K, const u16* W, int l, int gslot, float coef, bool from_input, char* smem) {
  char* ws = PWS;
  const float* mod = (const float*)(ws + OFF_MOD) + (size_t)l * 5 * NMODC + gslot * D;
  float* xo = (float*)(ws + OFF_X);
  const int tid = tidx(), wid = tid >> 6, lane = tid & 63, wr = wid >> 1, wc = wid & 1, fr = lane & 15, fq = lane >> 4;
  constexpr int nM = 32, nN = 8;
  auto get = [&](int tile) { int tm, tn; const bool ok = tile_xcd(tile, nM, nN, tm, tn); return TileDesc{A + (size_t)tm * TM * lda, W + (size_t)tn * 128 * K, lda, K, ok ? K / BK : 0}; };
  auto epi = [&](int tile, f32x4 (&acc)[4][4]) {
    int tm, tn; tile_xcd(tile, nM, nN, tm, tn);
#pragma unroll
    for (int m = 0; m < 4; ++m) {
      const int row = tm * TM + wr * 64 + m * 16 + fr;
      const float* xs = x_row(p, from_input, row);
      const float* gv = mod + (size_t)mod_row(row) * NMODC;
#pragma unroll
      for (int n = 0; n < 4; ++n) {
        const int col = tn * 128 + wc * 64 + n * 16 + fq * 4;
        const float4 xv = *(const float4*)(xs + col), g = *(const float4*)(gv + col);
        float4 o = {xv.x + coef * g.x * acc[m][n][0], xv.y + coef * g.y * acc[m][n][1], xv.z + coef * g.z * acc[m][n][2], xv.w + coef * g.w * acc[m][n][3]};
        *(float4*)(xo + (size_t)row * D + col) = o;
      }
    }
  };
  gemm_stream(nM * nN, get, epi, smem);
}

DEVI void phase_win(const Params& p, int l, char* smem) {
  char* ws = PWS;
  const u16* H = (const u16*)(ws + OFF_H);
  const u16* W = (const u16*)(ws + OFF_WIN + l * SZ_WIN);
  const int tid = tidx(), wid = tid >> 6, lane = tid & 63, wr = wid >> 1, wc = wid & 1, fr = lane & 15, fq = lane >> 4;
  constexpr int NF = 64, nM = 32, nN = 22;
  auto get = [&](int tile) {
    if (tile < NF) return TileDesc{W, H + (size_t)tile * 128 * LDH, D, LDH, D / BK};
    int tm, tn; tile_mn(tile - NF, nM, nN, tm, tn);
    return TileDesc{H + (size_t)tm * TM * LDH, W + (size_t)(tn + 2) * 128 * D, LDH, D, D / BK};
  };
  auto epi = [&](int tile, f32x4 (&acc)[4][4]) {
    if (tile < NF) {
      u16* finT = (u16*)(ws + OFF_FINT);
      const int t0 = tile * 128;
      int tb, np;
      if (t0 < TCTX) { tb = t0 & ~255; np = 256; } else { tb = TCTX + ((t0 - TCTX) & ~1023); np = 1024; }
#pragma unroll
      for (int m = 0; m < 4; ++m) {
        const int ch = wr * 64 + m * 16 + fr;
#pragma unroll
        for (int n = 0; n < 4; ++n) {
          const int pos = t0 - tb + wc * 64 + n * 16 + fq * 4;
          st_bf4(finT + (size_t)tb * 256 + (size_t)ch * np + pos, acc[m][n][0], acc[m][n][1], acc[m][n][2], acc[m][n][3]);
        }
      }
    } else {
      int tm, tn; tile_mn(tile - NF, nM, nN, tm, tn);
      tn += 2;
      const float* qg = p.in[15] + l * 384;
      const float* kg = p.in[17] + l * 256;
      const float* rt = (const float*)(ws + OFF_ROPE);
#pragma unroll
      for (int m = 0; m < 4; ++m) {
        const int row = tm * TM + wr * 64 + m * 16 + fr;
        int keyrow, npos = 0;
        if (row < TCTX) keyrow = row;
        else { const int b = (row - TCTX) >> 10; npos = (row - TCTX) & 1023; keyrow = TCTX + b * 1536 + npos; }
        float ss = 0.f;
#pragma unroll
        for (int n = 0; n < 4; ++n) {
          const int c = wc * 64 + n * 16 + fq * 4;
          const f32x4 a = acc[m][n];
          if (tn < 5) {
            const int col = (tn - 2) * 128 + c;
            const float4 g = *(const float4*)(qg + col);
            ss += a[0] * a[0] + a[1] * a[1] + a[2] * a[2] + a[3] * a[3];
            st_bf4((u16*)(ws + OFF_QN) + (size_t)row * 384 + col, a[0] * g.x, a[1] * g.y, a[2] * g.z, a[3] * g.w);
          } else if (tn < 7) {
            const int col = (tn - 5) * 128 + c;
            const float4 g = *(const float4*)(kg + col);
            ss += a[0] * a[0] + a[1] * a[1] + a[2] * a[2] + a[3] * a[3];
            const float4 v = {a[0] * g.x, a[1] * g.y, a[2] * g.z, a[3] * g.w};
            st_bf4((u16*)(ws + OFF_KEYCKV) + (size_t)keyrow * 256 + col, v.x, v.y, v.z, v.w);
            if (row < TCTX) {
              const int b = row >> 8, nn = row & 255;
              *(float4*)(p.out + 8388608 + ((size_t)(b * 2 + l) * 256 + nn) * 256 + col) = v;
            }
          } else if (tn == 7) {
            if (c < 32) {
              if (row < TCTX) {
                const int b = row >> 8, nn = row & 255;
                *(float4*)(p.out + 10485760 + ((size_t)(b * 2 + l) * 256 + nn) * 32 + c) = float4{a[0], a[1], a[2], a[3]};
                st_bf4((u16*)(ws + OFF_KEYROPE) + (size_t)keyrow * 32 + c, a[0], a[1], a[2], a[3]);
              } else {
                f32x4 pr, o;
#pragma unroll
                for (int j = 0; j < 4; ++j) pr[j] = shx(a[j], 32, lane);
#pragma unroll
                for (int j = 0; j < 4; ++j) {
                  const int f = (fq & 1) * 4 + j;
                  const float cs = rt[npos * 32 + n * 8 + f], sn = rt[npos * 32 + 16 + n * 8 + f];
                  o[j] = (fq < 2) ? a[j] * cs - pr[j] * sn : a[j] * cs + pr[j] * sn;
                }
                st_bf4((u16*)(ws + OFF_KEYROPE) + (size_t)keyrow * 32 + c, o[0], o[1], o[2], o[3]);
              }
            }
          } else if (tn < 16) {
            st_bf4((u16*)(ws + OFF_SGF) + (size_t)row * D + (tn - 8) * 128 + c, sigmf(a[0]), sigmf(a[1]), sigmf(a[2]), sigmf(a[3]));
          } else {
            st_bf4((u16*)(ws + OFF_SGA) + (size_t)row * D + (tn - 16) * 128 + c, sigmf(a[0]), sigmf(a[1]), sigmf(a[2]), sigmf(a[3]));
          }
        }
        if (tn < 7) {
          ss += shx(ss, 16, lane);
          ss += shx(ss, 32, lane);
          if (fq == 0) {
            if (tn < 5) ((float*)(ws + OFF_PQ))[(size_t)row * 8 + (tn - 2) * 2 + wc] = ss;
            else        ((float*)(ws + OFF_PK))[(size_t)row * 4 + (tn - 5) * 2 + wc] = ss;
          }
        }
      }
    }
  };
  gemm_stream(NF + nM * nN, get, epi, smem);
}

DEVI void phase_qkv_dft(const Params& p, int l, char* smem) {
  char* ws = PWS;
  const int tid = tidx(), wid = tid >> 6, lane = tid & 63, wr = wid >> 1, wc = wid & 1, fr = lane & 15, fq = lane >> 4;
  constexpr int NDL = 4 * 8 * 2, NDC = 16 * 2 * 2, NQ = 32 * 6, NKN = 40 * 4, NVT = 2 * 80;
  constexpr int E0 = NDL, E1 = E0 + NDC, E2 = E1 + NQ, E3 = E2 + NKN, E4 = E3 + NVT;
  const float* rt = (const float*)(ws + OFF_ROPE);
  const float* pq = (const float*)(ws + OFF_PQ);
  const float* pk = (const float*)(ws + OFF_PK);
  auto rs_q = [&](int row) {
    const float4 a = *(const float4*)(pq + (size_t)row * 8);
    const float2 b2 = *(const float2*)(pq + (size_t)row * 8 + 4);
    return rsqrtf((a.x + a.y + a.z + a.w + b2.x + b2.y) * (1.f / 384.f) + EPS);
  };
  auto rs_key = [&](int keyrow) {
    int tok;
    if (keyrow < TCTX) tok = keyrow;
    else { const int r = keyrow - TCTX, b = r / 1536, n = r - b * 1536; if (n >= 1024) return 1.f; tok = TCTX + b * 1024 + n; }
    const float4 a = *(const float4*)(pk + (size_t)tok * 4);
    return rsqrtf((a.x + a.y + a.z + a.w) * (1.f / 256.f) + EPS);
  };
  {
    const int gw = blockIdx.x * NWV + wid, nw = gridDim.x * NWV;
    for (int t = gw; t < TCTX; t += nw) {
      const float rs = rs_key(t);
      const int b = t >> 8, nn = t & 255;
      float4* o = (float4*)(p.out + 8388608 + ((size_t)(b * 2 + l) * 256 + nn) * 256 + lane * 4);
      float4 v = *o;
      v.x *= rs; v.y *= rs; v.z *= rs; v.w *= rs;
      *o = v;
    }
  }
  auto remap = [&](int idx) -> int {
    if (gridDim.x != 256) return idx < E4 ? idx : -1;
    const int b = idx & 255, t = idx >> 8;
    if (b < 64) return t == 0 ? b : -1;
    if (t >= 3) return -1;
    int j = (b - 64) + t * 192;
    if (j < 192) return E1 + j;
    j -= 192;
    if (j < 64) return E0 + j;
    return E2 + (j - 64);
  };
  auto get = [&](int idx) {
    const int tile = remap(idx);
    if (tile < 0) return TileDesc{nullptr, nullptr, 0, 0, 0};
    if (tile < E0) {
      const int b = tile >> 4, r = tile & 15, tm = r >> 1, tn = r & 1;
      return TileDesc{(const u16*)(ws + OFF_CSLAT) + (size_t)tm * TM * 1024,
                      (const u16*)(ws + OFF_FINT) + (size_t)(TCTX + b * 1024) * 256 + (size_t)tn * 128 * 1024, 1024, 1024, 16};
    } else if (tile < E1) {
      const int id = tile - E0, b = id >> 2, r = id & 3, tm = r >> 1, tn = r & 1;
      return TileDesc{(const u16*)(ws + OFF_CSCTX) + (size_t)tm * TM * 256,
                      (const u16*)(ws + OFF_FINT) + (size_t)(b * 256) * 256 + (size_t)tn * 128 * 256, 256, 256, 4};
    } else if (tile < E2) {
      int tm, tn; tile_mn(tile - E1, 32, 6, tm, tn);
      return TileDesc{(const u16*)(ws + OFF_QN) + (size_t)tm * TM * 384, (const u16*)(ws + OFF_WUQ + l * SZ_WUQ) + (size_t)tn * 128 * 384, 384, 384, 6};
    } else if (tile < E3) {
      int tm, tn; tile_mn(tile - E2, 40, 4, tm, tn);
      return TileDesc{(const u16*)(ws + OFF_KEYCKV) + (size_t)tm * TM * 256, (const u16*)(ws + OFF_WUKV + l * SZ_WUKV) + (size_t)tn * 128 * 256, 256, 256, 4};
    } else {
      const int id = tile - E3, vh = id / 80, kt = id % 80;
      return TileDesc{(const u16*)(ws + OFF_WUKV + l * SZ_WUKV) + (size_t)(512 + vh * 256) * 256, (const u16*)(ws + OFF_KEYCKV) + (size_t)kt * 128 * 256, 256, 256, 4};
    }
  };
  auto epi = [&](int idx, f32x4 (&acc)[4][4]) {
    const int tile = remap(idx);
    if (tile < E0) {
      const int b = tile >> 4, r = tile & 15, tm = r >> 1, tn = r & 1;
      u16* ycs = (u16*)(ws + OFF_YCS);
#pragma unroll
      for (int m = 0; m < 4; ++m) {
        const int rr = tm * TM + wr * 64 + m * 16 + fr;
        const size_t tok = TCTX + b * 1024 + (rr & 1023);
#pragma unroll
        for (int n = 0; n < 4; ++n) {
          const int col = (rr >> 10) * 256 + tn * 128 + wc * 64 + n * 16 + fq * 4;
          const float s = 1.f / 256.f;
          st_bf4(ycs + tok * 512 + col, acc[m][n][0] * s, acc[m][n][1] * s, acc[m][n][2] * s, acc[m][n][3] * s);
        }
      }
    } else if (tile < E1) {
      const int id = tile - E0, b = id >> 2, r = id & 3, tm = r >> 1, tn = r & 1;
      u16* ycs = (u16*)(ws + OFF_YCS);
#pragma unroll
      for (int m = 0; m < 4; ++m) {
        const int rr = tm * TM + wr * 64 + m * 16 + fr;
        const size_t tok = b * 256 + (rr & 255);
#pragma unroll
        for (int n = 0; n < 4; ++n) {
          const int col = (rr >> 8) * 256 + tn * 128 + wc * 64 + n * 16 + fq * 4;
          const float s = 1.f / 128.f;
          st_bf4(ycs + tok * 512 + col, acc[m][n][0] * s, acc[m][n][1] * s, acc[m][n][2] * s, acc[m][n][3] * s);
        }
      }
    } else if (tile < E2) {
      int tm, tn; tile_mn(tile - E1, 32, 6, tm, tn);
      u16* qf = (u16*)(ws + OFF_QF);
#pragma unroll
      for (int m = 0; m < 4; ++m) {
        const int row = tm * TM + wr * 64 + m * 16 + fr;
        const float rsq = rs_q(row);
#pragma unroll
        for (int n = 0; n < 4; ++n) {
          const int c0 = tn * 128 + wc * 64 + n * 16;
          const int off = c0 % 96;
          f32x4 a = acc[m][n] * rsq;
          if (off >= 64 && tm >= 16) {
            const int ax = (off - 64) >> 4;
            const int npos = (row - TCTX) & 1023;
            f32x4 pr;
#pragma unroll
            for (int j = 0; j < 4; ++j) pr[j] = shx(a[j], 32, lane);
#pragma unroll
            for (int j = 0; j < 4; ++j) {
              const int f = (fq & 1) * 4 + j;
              const float c = rt[npos * 32 + ax * 8 + f], s = rt[npos * 32 + 16 + ax * 8 + f];
              a[j] = (fq < 2) ? a[j] * c - pr[j] * s : a[j] * c + pr[j] * s;
            }
          }
          st_bf4(qf + (size_t)row * 768 + c0 + fq * 4, a[0], a[1], a[2], a[3]);
        }
      }
    } else if (tile < E3) {
      int tm, tn; tile_mn(tile - E2, 40, 4, tm, tn);
      u16* kn = (u16*)(ws + OFF_KNOPE);
#pragma unroll
      for (int m = 0; m < 4; ++m) {
        const int row = tm * TM + wr * 64 + m * 16 + fr;
        const float rsk = rs_key(row);
#pragma unroll
        for (int n = 0; n < 4; ++n)
          st_bf4(kn + (size_t)row * 512 + tn * 128 + wc * 64 + n * 16 + fq * 4, acc[m][n][0] * rsk, acc[m][n][1] * rsk, acc[m][n][2] * rsk, acc[m][n][3] * rsk);
      }
    } else {
      const int id = tile - E3, vh = id / 80, kt = id % 80;
      u16* vt = (u16*)(ws + OFF_VT);
      const int k0 = kt * 128;
      int kb, M;
      if (k0 < TCTX) { kb = k0 & ~255; M = 256; } else { kb = TCTX + ((k0 - TCTX) / 1536) * 1536; M = 1536; }
      float rk[4][4];
#pragma unroll
      for (int n = 0; n < 4; ++n)
#pragma unroll
        for (int j = 0; j < 4; ++j) rk[n][j] = rs_key(k0 + wc * 64 + n * 16 + fq * 4 + j);
#pragma unroll
      for (int m = 0; m < 4; ++m) {
        const int vc = vh * 256 + wr * 64 + m * 16 + fr;
#pragma unroll
        for (int n = 0; n < 4; ++n) {
          const int kl = k0 - kb + wc * 64 + n * 16 + fq * 4;
          st_bf4(vt + (size_t)kb * 512 + (size_t)vc * M + kl, acc[m][n][0] * rk[n][0], acc[m][n][1] * rk[n][1], acc[m][n][2] * rk[n][2], acc[m][n][3] * rk[n][3]);
        }
      }
    }
  };
  gemm_stream(768, get, epi, smem);
}

constexpr int AT_KN = 0, AT_RP = 16384, AT_VT = 24576, AT_STAGE = 40960;
DEVI void attn_block(const Params& p, int bt, char* smem) {
  const int tid = tidx(), wid = tid >> 6, lane = tid & 63, fr = lane & 15, fq = lane >> 4;
  const int qg = wid & 3, kh = wid >> 2;
  int M, keybase, tokb, h;
  if (bt < 256) { const int b = bt >> 6; h = (bt >> 3) & 7; M = 1536; keybase = TCTX + b * 1536; tokb = TCTX + b * 1024 + (bt & 7) * 128 + qg * 32; }
  else { const int id = bt - 256, b = id >> 4; h = (id >> 1) & 7; M = 256; keybase = b * 256; tokb = b * 256 + (id & 1) * 128 + qg * 32; }
  char* ws = PWS;
  bf16x8 qfrag[2][3];
#pragma unroll
  for (int qt = 0; qt < 2; ++qt) {
    const u16* qf = (const u16*)(ws + OFF_QF) + (size_t)(tokb + qt * 16 + fr) * 768 + h * 96 + fq * 8;
#pragma unroll
    for (int ks = 0; ks < 3; ++ks) qfrag[qt][ks] = *(const bf16x8*)(qf + ks * 32);
  }
  const u16* gk = (const u16*)(ws + OFF_KNOPE) + (size_t)(keybase + (tid >> 3)) * 512 + h * 64 + (((tid & 7) ^ ((tid >> 4) & 7)) * 8);
  const u16* gr = (const u16*)(ws + OFF_KEYROPE) + (size_t)(keybase + (tid >> 2)) * 32 + (((tid & 3) ^ ((-(tid >> 4)) & 3)) * 8);
  const u16* gv = (const u16*)(ws + OFF_VT) + (size_t)keybase * 512 + (size_t)(h * 64 + (tid >> 4)) * M + (((tid & 15) ^ ((tid >> 4) & 15)) * 8);
  auto stage = [&](int kt, int buf) {
    char* s = smem + buf * AT_STAGE + tid * 16;
    const int k0 = kt * 128;
    glds16(gk + (size_t)k0 * 512, s + AT_KN);
    glds16(gk + (size_t)(k0 + 64) * 512, s + AT_KN + 8192);
    glds16(gr + (size_t)k0 * 32, s + AT_RP);
    glds16(gv + k0, s + AT_VT);
    glds16(gv + (size_t)32 * M + k0, s + AT_VT + 8192);
  };
  f32x4 o[2][4];
#pragma unroll
  for (int qt = 0; qt < 2; ++qt)
#pragma unroll
    for (int i = 0; i < 4; ++i) o[qt][i] = f32x4{0.f, 0.f, 0.f, 0.f};
  float mrun[2] = {-1e30f, -1e30f}, lsum[2] = {0.f, 0.f};
  const float sc = 0.10206207261596577f * 1.4426950408889634f;
  const int nt = M >> 7;
  const int kswz = fr >> 1, rswz = (-(fr >> 2)) & 3;
  asm volatile("s_waitcnt vmcnt(0)" ::: "memory");
  stage(0, 0);
  stage(1, 1);
  int buf = 0;
  for (int t = 0; t < nt; ++t) {
    if (t + 1 < nt) asm volatile("s_waitcnt vmcnt(5)" ::: "memory");
    else            asm volatile("s_waitcnt vmcnt(0)" ::: "memory");
    __builtin_amdgcn_s_barrier();
    asm volatile("" ::: "memory");
    if (t + 2 < nt) stage(t + 2, buf >= 1 ? buf - 1 : 2);
    const char* sb = smem + buf * AT_STAGE;
    bf16x8 kf[3][2][2];
#pragma unroll
    for (int ks = 0; ks < 3; ++ks)
#pragma unroll
      for (int s2 = 0; s2 < 2; ++s2)
#pragma unroll
        for (int tt = 0; tt < 2; ++tt) {
          const int kr = (kh * 2 + s2) * 32 + tt * 16 + fr;
          kf[ks][s2][tt] = ks < 2 ? *(const bf16x8*)(sb + AT_KN + kr * 128 + ((ks * 4 + fq) ^ kswz) * 16)
                                  : *(const bf16x8*)(sb + AT_RP + kr * 64 + (fq ^ rswz) * 16);
        }
    __builtin_amdgcn_sched_barrier(0);
    f32x4 s[2][2][2];
#pragma unroll
    for (int qt = 0; qt < 2; ++qt)
#pragma unroll
      for (int s2 = 0; s2 < 2; ++s2)
#pragma unroll
        for (int tt = 0; tt < 2; ++tt) s[qt][s2][tt] = f32x4{0.f, 0.f, 0.f, 0.f};
    __builtin_amdgcn_s_setprio(1);
#pragma unroll
    for (int ks = 0; ks < 3; ++ks)
#pragma unroll
      for (int s2 = 0; s2 < 2; ++s2)
#pragma unroll
        for (int tt = 0; tt < 2; ++tt)
#pragma unroll
          for (int qt = 0; qt < 2; ++qt)
            s[qt][s2][tt] = __builtin_amdgcn_mfma_f32_16x16x32_bf16(kf[ks][s2][tt], qfrag[qt][ks], s[qt][s2][tt], 0, 0, 0);
    __builtin_amdgcn_s_setprio(0);
    __builtin_amdgcn_sched_barrier(0);
    bf16x4 vf[2][4][2];
#pragma unroll
    for (int s2 = 0; s2 < 2; ++s2)
#pragma unroll
      for (int dt = 0; dt < 4; ++dt) {
        const int c0 = (kh * 2 + s2) * 4 + (fq >> 1);
        vf[s2][dt][0] = *(const bf16x4*)(sb + AT_VT + (dt * 16 + fr) * 256 + (((c0) ^ fr) * 16) + (fq & 1) * 8);
        vf[s2][dt][1] = *(const bf16x4*)(sb + AT_VT + (dt * 16 + fr) * 256 + (((c0 + 2) ^ fr) * 16) + (fq & 1) * 8);
      }
    __builtin_amdgcn_sched_barrier(0);
    bf16x8 pfr[2][2];
#pragma unroll
    for (int qt = 0; qt < 2; ++qt) {
      float mx = -1e30f;
#pragma unroll
      for (int s2 = 0; s2 < 2; ++s2)
#pragma unroll
        for (int tt = 0; tt < 2; ++tt)
          mx = fmaxf(mx, fmaxf(fmaxf(s[qt][s2][tt][0], s[qt][s2][tt][1]), fmaxf(s[qt][s2][tt][2], s[qt][s2][tt][3])));
      mx = fmaxf(mx, shx(mx, 16, lane));
      mx = fmaxf(mx, shx(mx, 32, lane));
      const float mnew = fmaxf(mrun[qt], mx);
      const float alpha = __builtin_amdgcn_exp2f((mrun[qt] - mnew) * sc);
      mrun[qt] = mnew;
      const float mb = mnew * sc;
      float ps = 0.f;
#pragma unroll
      for (int s2 = 0; s2 < 2; ++s2) {
        float pv[8];
#pragma unroll
        for (int tt = 0; tt < 2; ++tt)
#pragma unroll
          for (int j = 0; j < 4; ++j) { pv[tt * 4 + j] = __builtin_amdgcn_exp2f(s[qt][s2][tt][j] * sc - mb); ps += pv[tt * 4 + j]; }
        union { bf16x8 v; unsigned u[4]; } pf;
        pf.u[0] = pk2(pv[0], pv[1]); pf.u[1] = pk2(pv[2], pv[3]); pf.u[2] = pk2(pv[4], pv[5]); pf.u[3] = pk2(pv[6], pv[7]);
        pfr[qt][s2] = pf.v;
      }
      lsum[qt] = lsum[qt] * alpha + ps;
#pragma unroll
      for (int dt = 0; dt < 4; ++dt) o[qt][dt] *= alpha;
    }
    __builtin_amdgcn_sched_barrier(0);
    __builtin_amdgcn_s_setprio(1);
#pragma unroll
    for (int s2 = 0; s2 < 2; ++s2)
#pragma unroll
      for (int dt = 0; dt < 4; ++dt) {
        const bf16x8 vfr = __builtin_shufflevector(vf[s2][dt][0], vf[s2][dt][1], 0, 1, 2, 3, 4, 5, 6, 7);
#pragma unroll
        for (int qt = 0; qt < 2; ++qt) o[qt][dt] = __builtin_amdgcn_mfma_f32_16x16x32_bf16(vfr, pfr[qt][s2], o[qt][dt], 0, 0, 0);
      }
    __builtin_amdgcn_s_setprio(0);
    __builtin_amdgcn_sched_barrier(0);
    buf = buf == 2 ? 0 : buf + 1;
  }
#pragma unroll
  for (int qt = 0; qt < 2; ++qt) { lsum[qt] += shx(lsum[qt], 16, lane); lsum[qt] += shx(lsum[qt], 32, lane); }
  asm volatile("s_waitcnt lgkmcnt(0)" ::: "memory");
  __builtin_amdgcn_s_barrier();
  asm volatile("" ::: "memory");
  float* xch = (float*)smem + (size_t)(qg * 64 + lane) * 40;
  if (kh == 1) {
#pragma unroll
    for (int qt = 0; qt < 2; ++qt) {
#pragma unroll
      for (int dt = 0; dt < 4; ++dt) *(f32x4*)(xch + qt * 20 + dt * 4) = o[qt][dt];
      xch[qt * 20 + 16] = mrun[qt];
      xch[qt * 20 + 17] = lsum[qt];
    }
  }
  asm volatile("s_waitcnt lgkmcnt(0)" ::: "memory");
  __builtin_amdgcn_s_barrier();
  asm volatile("" ::: "memory");
  if (kh == 0) {
#pragma unroll
    for (int qt = 0; qt < 2; ++qt) {
      const float m1 = xch[qt * 20 + 16], l1 = xch[qt * 20 + 17];
      const float mm = fmaxf(mrun[qt], m1);
      const float a0 = __builtin_amdgcn_exp2f((mrun[qt] - mm) * sc), a1 = __builtin_amdgcn_exp2f((m1 - mm) * sc);
      const float inv = 1.f / (lsum[qt] * a0 + l1 * a1);
      u16* op = (u16*)(ws + OFF_O) + (size_t)(tokb + qt * 16 + fr) * 512 + h * 64 + fq * 4;
#pragma unroll
      for (int dt = 0; dt < 4; ++dt) {
        const f32x4 o1 = *(const f32x4*)(xch + qt * 20 + dt * 4);
        st_bf4(op + dt * 16, (o[qt][dt][0] * a0 + o1[0] * a1) * inv, (o[qt][dt][1] * a0 + o1[1] * a1) * inv,
               (o[qt][dt][2] * a0 + o1[2] * a1) * inv, (o[qt][dt][3] * a0 + o1[3] * a1) * inv);
      }
    }
  }
  asm volatile("s_waitcnt lgkmcnt(0)" ::: "memory");
  __builtin_amdgcn_s_barrier();
  asm volatile("" ::: "memory");
}

DEVI void phase_attn_amix(const Params& p, int l, char* smem) {
  for (int bt = blockIdx.x; bt < 512; bt += gridDim.x) attn_block(p, bt, smem);
}

DEVI void phase_merge(const Params& p, int l, char* smem) {
  char* ws = PWS;
  const int tid = tidx(), wid = tid >> 6, lane = tid & 63, wr = wid >> 1, wc = wid & 1, fr = lane & 15, fq = lane >> 4;
  const u16* YC = (const u16*)(ws + OFF_YCS);
  const u16* W4 = (const u16*)(ws + OFF_W4F + l * SZ_W4F);
  const u16* O = (const u16*)(ws + OFF_O);
  const u16* WA = (const u16*)(ws + OFF_WAP + l * SZ_WAP);
  const u16* sgf = (const u16*)(ws + OFF_SGF);
  const u16* sga = (const u16*)(ws + OFF_SGA);
  u16* mg = (u16*)(ws + OFF_H);
  const int G = gridDim.x;
  uint2 stash[4][4];
  auto decode = [&](int idx, int& pair, int& part) { const int t = idx / G, b = idx - t * G; pair = b + (t >> 1) * G; part = t & 1; };
  auto get = [&](int idx) {
    int pair, part; decode(idx, pair, part);
    int tm, tn; const bool ok = pair < 256 && tile_xcd(pair, 32, 8, tm, tn);
    if (!ok) return TileDesc{nullptr, nullptr, 0, 0, 0};
    return part == 0 ? TileDesc{YC + (size_t)tm * TM * 512, W4 + (size_t)tn * 128 * 512, 512, 512, 8}
                     : TileDesc{O + (size_t)tm * TM * 512, WA + (size_t)tn * 128 * 512, 512, 512, 8};
  };
  auto epi = [&](int idx, f32x4 (&acc)[4][4]) {
    int pair, part; decode(idx, pair, part);
    int tm, tn; tile_xcd(pair, 32, 8, tm, tn);
#pragma unroll
    for (int m = 0; m < 4; ++m) {
      const int row = tm * TM + wr * 64 + m * 16 + fr;
#pragma unroll
      for (int n = 0; n < 4; ++n) {
        const int col = tn * 128 + wc * 64 + n * 16 + fq * 4;
        if (part == 0) {
          const uint2 g = *(const uint2*)(sgf + (size_t)row * D + col);
          stash[m][n].x = pk2(bf2f(g.x & 0xffff) * acc[m][n][0], bf2f(g.x >> 16) * acc[m][n][1]);
          stash[m][n].y = pk2(bf2f(g.y & 0xffff) * acc[m][n][2], bf2f(g.y >> 16) * acc[m][n][3]);
        } else {
          const uint2 g = *(const uint2*)(sga + (size_t)row * D + col);
          const uint2 a = stash[m][n];
          st_bf4(mg + (size_t)row * LDH + col, bf2f(a.x & 0xffff) + bf2f(g.x & 0xffff) * acc[m][n][0],
                 bf2f(a.x >> 16) + bf2f(g.x >> 16) * acc[m][n][1], bf2f(a.y & 0xffff) + bf2f(g.y & 0xffff) * acc[m][n][2],
                 bf2f(a.y >> 16) + bf2f(g.y >> 16) * acc[m][n][3]);
        }
      }
    }
  };
  gemm_stream(2 * ((256 + G - 1) / G) * G, get, epi, smem);
}

#define XB_TMO      128
#define XB_XCNT(j)  (256  + 64 * (j))
#define XB_XSUB(j)  (1280 + 64 * (j))
#define XB_XGEN(j)  (2304 + 64 * (j))
#define XB_TOP      3328
#define XB_TOPGEN   3392
#define XCD_BAR_WORDS 3456
#define XB_SPIN_CAP (1u << 18)
#define LAS __attribute__((address_space(3)))
DEVI unsigned xb_ld(unsigned* p)              { return __hip_atomic_load(p, __ATOMIC_RELAXED, __HIP_MEMORY_SCOPE_AGENT); }
DEVI unsigned xb_add(unsigned* p, unsigned v) { return __hip_atomic_fetch_add(p, v, __ATOMIC_RELAXED, __HIP_MEMORY_SCOPE_AGENT); }
DEVI unsigned xb_xcc_id() { return (unsigned)__builtin_amdgcn_s_getreg((3 << 11) | 20) & 0xFu; }
#define XB_SPIN(cond, bar) do { unsigned _sp = 0; while (cond) { __builtin_amdgcn_s_sleep(1); \
    if ((++_sp & 255u) == 0u) { if (xb_ld(&(bar)[XB_TMO])) break; if (_sp > XB_SPIN_CAP) { atomicAdd(&(bar)[XB_TMO], 1u); break; } } } } while (0)
struct XcdBarrier { unsigned* bar; unsigned x; volatile LAS unsigned* st; };
DEVI XcdBarrier xcd_barrier_post(unsigned* bar, volatile LAS unsigned* st) {
  XcdBarrier b; b.bar = bar; b.x = xb_xcc_id(); b.st = st;
  if (threadIdx.x == 0) (void)xb_add(&bar[XB_XCNT(b.x)], 1u);
  return b;
}
DEVI void xcd_barrier_complete(unsigned* bar, unsigned x, unsigned& nloc, unsigned& nx) {
  const unsigned G = gridDim.x * gridDim.y * gridDim.z;
  unsigned sum, cnt, mine, sp = 0u;
  for (;;) {
    sum = 0u; cnt = 0u; mine = 0u;
#pragma unroll
    for (unsigned j = 0; j < 16; ++j) { const unsigned c = xb_ld(&bar[XB_XCNT(j)]); sum += c; cnt += (c > 0u) ? 1u : 0u; mine = (j == x) ? c : mine; }
    if (sum == G) break;
    __builtin_amdgcn_s_sleep(1);
    if ((++sp & 255u) == 0u) { if (xb_ld(&bar[XB_TMO])) break; if (sp > XB_SPIN_CAP) { atomicAdd(&bar[XB_TMO], 1u); break; } }
  }
  nloc = mine > 0u ? mine : 1u; nx = cnt > 0u ? cnt : 1u;
}
DEVI void xcd_barrier(const XcdBarrier& b) {
  asm volatile("s_waitcnt vmcnt(0)" ::: "memory");
  __syncthreads();
  if (threadIdx.x == 0) {
    unsigned* bar = b.bar;
    __builtin_amdgcn_s_waitcnt(0);
    unsigned nloc = b.st[0], nx = b.st[1];
    if (nloc == 0u) { xcd_barrier_complete(bar, b.x, nloc, nx); b.st[0] = nloc; b.st[1] = nx; }
    const unsigned old = xb_add(&bar[XB_XSUB(b.x)], 1u);
    const unsigned gen = old / nloc;
    if (old + 1u == (gen + 1u) * nloc) {
      __builtin_amdgcn_fence(__ATOMIC_RELEASE, "agent");
      asm volatile("s_waitcnt vmcnt(0)" ::: "memory");
      const unsigned og = xb_add(&bar[XB_TOP], 1u);
      const unsigned tg = og / nx;
      if (og + 1u == (tg + 1u) * nx) xb_add(&bar[XB_TOPGEN], 1u);
      else XB_SPIN(xb_ld(&bar[XB_TOPGEN]) == tg, bar);
      __builtin_amdgcn_fence(__ATOMIC_ACQUIRE, "agent");
      xb_add(&bar[XB_XGEN(b.x)], 1u);
      asm volatile("s_waitcnt vmcnt(0)" ::: "memory");
    } else {
      XB_SPIN(xb_ld(&bar[XB_XGEN(b.x)]) == gen, bar);
      __builtin_amdgcn_fence(__ATOMIC_ACQUIRE, "agent");
      asm volatile("s_waitcnt vmcnt(0)" ::: "memory");
    }
  }
  __syncthreads();
}

constexpr int NPH = 26;

DEVI void run_phase(const Params& p, int ph, char* smem) {
  if (ph == 0) { phase_prep(p, smem); return; }
  if (ph == NPH - 1) { phase_final(p); return; }
  const int l = (ph - 1) / 12, s = (ph - 1) % 12;
  switch (s) {
    case 0: phase_norm(p, l, 0, l == 0); break;
    case 1: phase_gu(p, l, 0, smem); break;
    case 2: phase_resid(p, (const u16*)(PWS + OFF_ACT), FF, FF, (const u16*)(PWS + OFF_WD + (l * 2 + 0) * SZ_WD), l, 2, 0.5f, l == 0, smem); break;
    case 3: phase_norm(p, l, 1, false); phase_cachecopy(p, l); break;
    case 4: phase_win(p, l, smem); break;
    case 5: phase_qkv_dft(p, l, smem); break;
    case 6: phase_attn_amix(p, l, smem); break;
    case 7: phase_merge(p, l, smem); break;
    case 8: phase_resid(p, (const u16*)(PWS + OFF_H), LDH, D, (const u16*)(PWS + OFF_WOUT + l * SZ_WOUT), l, 5, 1.0f, false, smem); break;
    case 9: phase_norm(p, l, 2, false); break;
    case 10: phase_gu(p, l, 1, smem); break;
    case 11: phase_resid(p, (const u16*)(PWS + OFF_ACT), FF, FF, (const u16*)(PWS + OFF_WD + (l * 2 + 1) * SZ_WD), l, 8, 0.5f, false, smem); break;
  }
}

__global__ void __launch_bounds__(512) mega(Params p, int ph0, int ph1) {
  extern __shared__ __attribute__((aligned(16))) char smem[];
  if (ph1 > 4096) cg::this_grid().sync();
  volatile LAS unsigned* st = (volatile LAS unsigned*)(smem + LDS_BYTES);
  if (threadIdx.x == 0) { st[0] = 0u; st[1] = 0u; st[2] = 0u; st[3] = 0u; }
  __syncthreads();
  (void)xcd_barrier_post((unsigned*)(p.ws + OFF_BAR), st);
  for (int ph = ph0; ph < ph1; ++ph) {
    run_phase(p, ph, smem);
#ifdef PROBE_S
    if (ph >= 1 && ph < NPH - 1 && ((ph - 1) % 12) == PROBE_S) run_phase(p, ph, smem);
#endif
#ifdef PROBE_PH
    if (ph == PROBE_PH) run_phase(p, ph, smem);
#endif
    if (ph + 1 < ph1) {
      {
        XcdBarrier xb; xb.bar = (unsigned*)(PWS + OFF_BAR); xb.x = xb_xcc_id();
        xb.st = (volatile LAS unsigned*)(smem + LDS_BYTES);
        xcd_barrier(xb);
      }

    }
  }
}

extern "C" void kernel_launch(void* const* d_in, const int* in_sizes, int n_in, void* d_out, int out_size, void* d_ws,
                              size_t ws_size, hipStream_t stream) {
  static int grid_blocks = 0;
  if (!grid_blocks) {
    int dev = 0, cus = 0, per_cu = 0;
    hipGetDevice(&dev);
    hipDeviceGetAttribute(&cus, hipDeviceAttributeMultiprocessorCount, dev);
    hipFuncSetAttribute((const void*)mega, hipFuncAttributeMaxDynamicSharedMemorySize, LDS_BYTES + 16);
    hipOccupancyMaxActiveBlocksPerMultiprocessor(&per_cu, mega, NT, LDS_BYTES + 16);
    if (per_cu < 1) per_cu = 1;
    grid_blocks = cus * per_cu;
  }
  if (ws_size < WS_TOTAL) { fprintf(stderr, "workspace too small: %zu < %zu\n", ws_size, (size_t)WS_TOTAL); return; }
  Params p{};
  for (int i = 0; i < 26; ++i) p.in[i] = (const float*)d_in[i];
  p.out = (float*)d_out;
  p.ws = (char*)d_ws;
  int ph0 = 0, ph1 = NPH;
  hipMemsetAsync((char*)d_ws + OFF_BAR, 0, 16384, stream);
  void* args[] = {&p, &ph0, &ph1};
  hipError_t e = hipLaunchCooperativeKernel((void*)mega, dim3(grid_blocks), dim3(NT), args, LDS_BYTES + 16, stream);
  if (e != hipSuccess) fprintf(stderr, "cooperative launch failed: %s (grid %d)\n", hipGetErrorString(e), grid_blocks);
}
```

```cpp
#include <hip/hip_runtime.h>
#include <hip/hip_bf16.h>
#include <hip/hip_cooperative_groups.h>
#include <cstdio>
namespace cg = cooperative_groups;

typedef unsigned short u16;
using bf16x8 = __attribute__((ext_vector_type(8))) short;
using bf16x4 = __attribute__((ext_vector_type(4))) short;
using f32x4  = __attribute__((ext_vector_type(4))) float;
#define DEVI __device__ __forceinline__

constexpr int D = 1024, T = 8192, TCTX = 4096, FF = 2816, NKEY = 10240;
constexpr int NMODC = 9216;
constexpr float EPS = 1e-6f;

constexpr int LDH = 1088, LDW = 1088;
static_assert(LDH == LDW, "gemm8p shares the staging offsets between A and B");
constexpr size_t SZ_WGU = 5632ull * LDW * 2, SZ_WD = 1024ull * 2816 * 2, SZ_WIN = 3072ull * 1024 * 2;
constexpr size_t SZ_W4F = 1024ull * 512 * 2, SZ_WUQ = 768ull * 384 * 2, SZ_WUKV = 1024ull * 256 * 2;
constexpr size_t SZ_WAP = 1024ull * 512 * 2, SZ_WOUT = 1024ull * 1024 * 2;
constexpr size_t OFF_WGU = 0;
constexpr size_t OFF_WD = OFF_WGU + 4 * SZ_WGU;
constexpr size_t OFF_WIN = OFF_WD + 4 * SZ_WD;
constexpr size_t OFF_W4F = OFF_WIN + 2 * SZ_WIN;
constexpr size_t OFF_WUQ = OFF_W4F + 2 * SZ_W4F;
constexpr size_t OFF_WUKV = OFF_WUQ + 2 * SZ_WUQ;
constexpr size_t OFF_WAP = OFF_WUKV + 2 * SZ_WUKV;
constexpr size_t OFF_WOUT = OFF_WAP + 2 * SZ_WAP;
constexpr size_t OFF_CSLAT = OFF_WOUT + 2 * SZ_WOUT;
constexpr size_t OFF_CSCTX = OFF_CSLAT + 2048ull * 1024 * 2;
constexpr size_t OFF_ROPE = OFF_CSCTX + 512ull * 256 * 2;
constexpr size_t OFF_MODPART = OFF_ROPE + 1024ull * 32 * 4;
constexpr size_t OFF_MOD = OFF_MODPART + 2ull * 32 * 5 * 9216 * 4;
constexpr size_t OFF_X = OFF_MOD + 2ull * 5 * 9216 * 4;
constexpr size_t OFF_H = OFF_X + 8192ull * 1024 * 4;
constexpr size_t OFF_ACT = OFF_H + 8192ull * LDH * 2;
constexpr size_t OFF_QLAT = OFF_ACT;
constexpr size_t OFF_CKV = OFF_QLAT + 8192ull * 384 * 4;
constexpr size_t OFF_KROPE = OFF_CKV + 8192ull * 256 * 4;
constexpr size_t OFF_FINT = OFF_KROPE + 8192ull * 32 * 4;
constexpr size_t OFF_QN = OFF_FINT + 8192ull * 256 * 2;
constexpr size_t OFF_YCS = OFF_QN + 8192ull * 384 * 2;
constexpr size_t OFF_AMIX = OFF_QLAT;
constexpr size_t OFF_SGF = OFF_ACT + 8192ull * 2816 * 2;
constexpr size_t OFF_SGA = OFF_SGF + 8192ull * 1024 * 2;
constexpr size_t OFF_QF = OFF_SGA + 8192ull * 1024 * 2;
constexpr size_t OFF_KNOPE = OFF_QF + 8192ull * 768 * 2;
constexpr size_t OFF_VT = OFF_KNOPE + 10240ull * 512 * 2;
constexpr size_t OFF_O = OFF_VT + 10240ull * 512 * 2;
constexpr size_t OFF_KEYCKV = OFF_O + 8192ull * 512 * 2;
constexpr size_t OFF_KEYROPE = OFF_KEYCKV + 10240ull * 256 * 2;
constexpr size_t OFF_PQ = OFF_KEYROPE + 10240ull * 32 * 2;
constexpr size_t OFF_PK = OFF_PQ + 8192ull * 8 * 4;
constexpr size_t OFF_BAR = OFF_PK + 8192ull * 4 * 4;
constexpr size_t WS_TOTAL = OFF_BAR + 16384;
static_assert(OFF_YCS + 8192ull * 512 * 2 <= OFF_SGF, "act alias overflow");

struct Params {
  const float* in[26];
  float* out;
  char* ws;
};
DEVI int tidx() { int t = threadIdx.x; asm volatile("" : "+v"(t)); return t; }
DEVI char* wsp(const Params& p) {
  typedef __attribute__((address_space(1))) char gchar;
  gchar* w = (gchar*)p.ws;
  asm volatile("" : "+s"(w));
  return (char*)w;
}
#define PWS (wsp(p))


DEVI unsigned pk2(float a, float b) {
  typedef __attribute__((ext_vector_type(2))) __bf16 bf2;
  typedef __attribute__((ext_vector_type(2))) float f2;
  f2 v = {a, b};
  bf2 r = __builtin_convertvector(v, bf2);
  return *(unsigned*)&r;
}
DEVI u16 f2bf(float a) { return (u16)(pk2(a, 0.f) & 0xffff); }
DEVI float bf2f(u16 h) { return __uint_as_float(((unsigned)h) << 16); }
DEVI void st_bf4(u16* dst, float a, float b, float c, float d) {
  uint2 v; v.x = pk2(a, b); v.y = pk2(c, d);
  *(uint2*)dst = v;
}
DEVI float shx(float v, int mask, int lane) {
  return __int_as_float(__builtin_amdgcn_ds_bpermute((lane ^ mask) << 2, __float_as_int(v)));
}
DEVI float4 ld_nt4(const float* p) {
  typedef float v4f __attribute__((ext_vector_type(4)));
  const v4f v = __builtin_nontemporal_load((const v4f*)p);
  return float4{v[0], v[1], v[2], v[3]};
}
DEVI float wave_sum(float v, int lane) {
#pragma unroll
  for (int o = 32; o > 0; o >>= 1) v += shx(v, o, lane);
  return v;
}
DEVI float siluf(float x) { return x * __builtin_amdgcn_rcpf(1.f + __expf(-x)); }
DEVI float sigmf(float x) { return __builtin_amdgcn_rcpf(1.f + __expf(-x)); }
DEVI int mod_row(int t) { return t < TCTX ? 0 : 1 + ((t - TCTX) >> 10); }

constexpr int NT = 512, NWV = 8;
constexpr int TM = 256, TN = 128, BK = 64;
constexpr int ROWB = BK * 2;
constexpr int A_TILE_B = TM * ROWB;
constexpr int B_TILE_B = TN * ROWB;
constexpr int STAGE_B = A_TILE_B + B_TILE_B;
constexpr int NSTAGE = 3;
constexpr int LDS_BYTES = NSTAGE * STAGE_B;
constexpr int KS = BK / 32;

DEVI void glds16(const void* g, void* l) {
  __builtin_amdgcn_global_load_lds((const unsigned*)g, (unsigned*)l, 16, 0, 0);
}

DEVI void zero_acc(f32x4 (&acc)[4][4]) {
#pragma unroll
  for (int m = 0; m < 4; ++m)
#pragma unroll
    for (int n = 0; n < 4; ++n) acc[m][n] = f32x4{0.f, 0.f, 0.f, 0.f};
}

DEVI bool tile_xcd(int idx, int nM, int nN, int& tm, int& tn) {
  const int x = idx & 7, s = idx >> 3;
  const int SN = (nN & 3) == 0 ? 4 : 2, per = 8 * SN;
  const int k = s / per, w = s % per;
  const int st = k * 8 + x, nsm = nM >> 3;
  const int sm = st % nsm, sn = st / nsm;
  tm = sm * 8 + (w & 7);
  tn = sn * SN + (w >> 3);
  return sn * SN < nN;
}
DEVI void tile_mn(int idx, int nM, int nN, int& tm, int& tn) {
  const int nig = 8 * nN, gid = idx / nig, fm = gid * 8, gsz = min(nM - fm, 8), r = idx % nig;
  tm = fm + (r % gsz);
  tn = r / gsz;
}


struct TileDesc { const u16* A; const u16* B; int lda, ldb, nt; };
DEVI void touch_frags(const bf16x8 (&a)[4], const bf16x8 (&b)[4]) {
  asm volatile("" ::"v"(a[0]), "v"(a[1]), "v"(a[2]), "v"(a[3]), "v"(b[0]), "v"(b[1]), "v"(b[2]), "v"(b[3]));
}

template <class GetTile, class Epi>
DEVI void gemm_stream(int ntiles, GetTile get_tile, Epi epi, char* smem) {
  const int tid = tidx(), wid = tid >> 6, lane = tid & 63, wr = wid >> 1, wc = wid & 1, fr = lane & 15, fq = lane >> 4;
  int nloc = 0;
  while ((int)blockIdx.x + nloc * (int)gridDim.x < ntiles && get_tile((int)blockIdx.x + nloc * (int)gridDim.x).nt > 0) ++nloc;
  if (nloc <= 0) return;
  const int srow = tid >> 3, schunk8 = ((tid & 7) ^ ((tid >> 4) & 7)) * 8;
  int it = 0, ikt = 0, ibuf = 0;
  TileDesc id = get_tile((int)blockIdx.x);
  const u16* ga = id.A + (size_t)srow * id.lda + schunk8;
  const u16* gb = id.B + (size_t)srow * id.ldb + schunk8;
  auto issue = [&]() -> bool {
    if (it >= nloc) return false;
    char* sa = smem + ibuf * STAGE_B + tid * 16;
    char* sb = sa + A_TILE_B;
#pragma unroll
    for (int i = 0; i < 4; ++i) glds16(ga + (size_t)(i * 64) * id.lda + ikt * BK, sa + i * 8192);
#pragma unroll
    for (int i = 0; i < 2; ++i) glds16(gb + (size_t)(i * 64) * id.ldb + ikt * BK, sb + i * 8192);
    ibuf = ibuf == 2 ? 0 : ibuf + 1;
    if (++ikt == id.nt) {
      ikt = 0; ++it;
      if (it < nloc) {
        id = get_tile((int)blockIdx.x + it * (int)gridDim.x);
        ga = id.A + (size_t)srow * id.lda + schunk8;
        gb = id.B + (size_t)srow * id.ldb + schunk8;
      }
    }
    return true;
  };
  const int fswz = fr >> 1;
  const int aoff = (wr * 64 + fr) * ROWB, boff = A_TILE_B + (wc * 64 + fr) * ROWB;
  const int p0 = (fq ^ fswz) * 16, p1 = ((4 + fq) ^ fswz) * 16;
  bf16x8 a0[4], b0[4], a1[4], b1[4];
  asm volatile("s_waitcnt vmcnt(0)" ::: "memory");
  issue();
  if (issue()) asm volatile("s_waitcnt vmcnt(6)" ::: "memory");
  else         asm volatile("s_waitcnt vmcnt(0)" ::: "memory");
  __builtin_amdgcn_s_barrier();
  asm volatile("" ::: "memory");
  int cbuf = 0;
#pragma unroll
  for (int m = 0; m < 4; ++m) a0[m] = *(const bf16x8*)(smem + aoff + m * 16 * ROWB + p0);
#pragma unroll
  for (int n = 0; n < 4; ++n) b0[n] = *(const bf16x8*)(smem + boff + n * 16 * ROWB + p0);
  touch_frags(a0, b0);
  for (int t = 0; t < nloc; ++t) {
    const int nt = get_tile((int)blockIdx.x + t * (int)gridDim.x).nt;
    f32x4 acc[4][4];
#pragma unroll
    for (int m = 0; m < 4; ++m)
#pragma unroll
      for (int n = 0; n < 4; ++n) acc[m][n] = f32x4{0.f, 0.f, 0.f, 0.f};
    for (int kt = 0; kt < nt; ++kt) {
      const bool issued = issue();
      const char* sb_ = smem + cbuf * STAGE_B;
#pragma unroll
      for (int m = 0; m < 4; ++m) a1[m] = *(const bf16x8*)(sb_ + aoff + m * 16 * ROWB + p1);
#pragma unroll
      for (int n = 0; n < 4; ++n) b1[n] = *(const bf16x8*)(sb_ + boff + n * 16 * ROWB + p1);
      __builtin_amdgcn_sched_barrier(0);
      __builtin_amdgcn_s_setprio(1);
#pragma unroll
      for (int m = 0; m < 4; ++m)
#pragma unroll
        for (int n = 0; n < 4; ++n) acc[m][n] = __builtin_amdgcn_mfma_f32_16x16x32_bf16(b0[n], a0[m], acc[m][n], 0, 0, 0);
      __builtin_amdgcn_s_setprio(0);
      __builtin_amdgcn_sched_barrier(0);
      touch_frags(a1, b1);
      asm volatile("s_waitcnt lgkmcnt(0)" ::: "memory");
      if (issued) asm volatile("s_waitcnt vmcnt(6)" ::: "memory");
      else        asm volatile("s_waitcnt vmcnt(0)" ::: "memory");
      __builtin_amdgcn_s_barrier();
      asm volatile("" ::: "memory");
      cbuf = cbuf == 2 ? 0 : cbuf + 1;
      if (kt + 1 < nt || t + 1 < nloc) {
        const char* sn = smem + cbuf * STAGE_B;
#pragma unroll
        for (int m = 0; m < 4; ++m) a0[m] = *(const bf16x8*)(sn + aoff + m * 16 * ROWB + p0);
#pragma unroll
        for (int n = 0; n < 4; ++n) b0[n] = *(const bf16x8*)(sn + boff + n * 16 * ROWB + p0);
      }
      __builtin_amdgcn_sched_barrier(0);
      __builtin_amdgcn_s_setprio(1);
#pragma unroll
      for (int m = 0; m < 4; ++m)
#pragma unroll
        for (int n = 0; n < 4; ++n) acc[m][n] = __builtin_amdgcn_mfma_f32_16x16x32_bf16(b1[n], a1[m], acc[m][n], 0, 0, 0);
      __builtin_amdgcn_s_setprio(0);
      __builtin_amdgcn_sched_barrier(0);
      touch_frags(a0, b0);
    }
    epi((int)blockIdx.x + t * (int)gridDim.x, acc);
  }
}


constexpr int P8_HT = 128 * 64;
DEVI int p8_lds_byte(int r, int c) {
  const int st = (r >> 4) * 2 + (c >> 5), rr = r & 15, cc = c & 31, ob = rr * 64 + cc * 2;
  return st * 1024 + (ob ^ (((ob >> 9) & 1) << 5));
}
DEVI void p8_stage_rc(int b, int& R, int& C) {
  const int st = b / 1024, sb = b % 1024, swz = sb ^ (((sb >> 9) & 1) << 5);
  R = (st >> 1) * 16 + swz / 64;
  C = (st & 1) * 32 + (swz % 64) / 2;
}
DEVI void gemm8p_tile(f32x4 (&acc)[2][2][4][2], const u16* __restrict__ A, int lda, const u16* __restrict__ Bt, int ldb, int K,
                      char* smem, bool primed) {
  u16* shm = (u16*)smem;
  const int tid = tidx();
  const int wid = tid >> 6, lane = tid & 63, wr = wid >> 2, wc = wid & 3, fr = lane & 15, fq = lane >> 4;
#define P8_SA(b, h) (shm + ((b) * 2 + (h)) * P8_HT)
#define P8_SB(b, h) (shm + (4 + (b) * 2 + (h)) * P8_HT)
  int sr0, sc0, sr1, sc1;
  p8_stage_rc(tid * 16, sr0, sc0);
  p8_stage_rc(tid * 16 + 8192, sr1, sc1);
  const unsigned oa0 = (unsigned)(sr0 * lda + sc0) * 2u, oa1 = (unsigned)(sr1 * lda + sc1) * 2u;
#define P8_STAGE_A(P, BASE, br, kt) do { const char* _g = (const char*)((BASE) + (size_t)(br) * lda + (kt) * 64); \
    glds16(_g + oa0, (char*)(P) + tid * 16); glds16(_g + oa1, (char*)(P) + tid * 16 + 8192); } while (0)
#define P8_STAGE_B(P, BASE, br, kt) do { const char* _g = (const char*)((BASE) + (size_t)(br) * ldb + (kt) * 64); \
    glds16(_g + oa0, (char*)(P) + tid * 16); glds16(_g + oa1, (char*)(P) + tid * 16 + 8192); } while (0)
#define P8_LDA(dst, b, h) for (int m = 0; m < 4; ++m) for (int k = 0; k < 2; ++k) \
    dst[m][k] = *reinterpret_cast<const bf16x8*>((char*)P8_SA(b, h) + p8_lds_byte(wr * 64 + m * 16 + fr, k * 32 + fq * 8))
#define P8_LDB(dst, b, h) for (int n = 0; n < 2; ++n) for (int k = 0; k < 2; ++k) \
    dst[n][k] = *reinterpret_cast<const bf16x8*>((char*)P8_SB(b, h) + p8_lds_byte(wc * 32 + n * 16 + fr, k * 32 + fq * 8))
#define P8_MMA(ai, bj, At_, Bt_) do { __builtin_amdgcn_s_setprio(1); \
    for (int m = 0; m < 4; ++m) for (int n = 0; n < 2; ++n) for (int k = 0; k < 2; ++k) \
      acc[ai][bj][m][n] = __builtin_amdgcn_mfma_f32_16x16x32_bf16(Bt_[n][k], At_[m][k], acc[ai][bj][m][n], 0, 0, 0); \
    __builtin_amdgcn_s_setprio(0); } while (0)
#define P8_WAIT_V(n) asm volatile("s_waitcnt vmcnt(" #n ")" ::: "memory")
#define P8_WAIT_L(n) asm volatile("s_waitcnt lgkmcnt(" #n ")" ::: "memory")
#define P8_BAR __builtin_amdgcn_s_barrier()
#define P8_SCHED __builtin_amdgcn_sched_barrier(0)
  bf16x8 At[4][2], B0[2][2], B1[2][2];
  const int nt = K / 64;
  if (!primed) {
    P8_WAIT_V(0);
    P8_STAGE_B(P8_SB(0, 0), Bt, 0, 0); P8_STAGE_A(P8_SA(0, 0), A, 0, 0);
    P8_STAGE_B(P8_SB(0, 1), Bt, 128, 0); P8_STAGE_A(P8_SA(0, 1), A, 128, 0);
  }
  if (wr == 1) P8_BAR;
  P8_WAIT_V(4); P8_BAR;
  P8_STAGE_B(P8_SB(1, 0), Bt, 0, 1); P8_STAGE_A(P8_SA(1, 0), A, 0, 1); P8_STAGE_B(P8_SB(1, 1), Bt, 128, 1);
  P8_WAIT_V(6); P8_BAR;
  for (int t = 0; t < nt - 2; t += 2) {
    P8_LDB(B0, 0, 0); P8_SCHED; P8_LDA(At, 0, 0); P8_STAGE_A(P8_SA(1, 1), A, 128, t + 1);
    P8_WAIT_L(8); P8_BAR; P8_WAIT_L(0); P8_MMA(0, 0, At, B0); P8_BAR; P8_SCHED;
    P8_LDB(B1, 0, 1); P8_STAGE_B(P8_SB(0, 0), Bt, 0, t + 2);
    P8_BAR; P8_WAIT_L(0); P8_MMA(0, 1, At, B1); P8_BAR;
    P8_LDA(At, 0, 1); P8_STAGE_A(P8_SA(0, 0), A, 0, t + 2);
    P8_BAR; P8_WAIT_L(0); P8_MMA(1, 0, At, B0); P8_BAR; P8_SCHED;
    P8_STAGE_B(P8_SB(0, 1), Bt, 128, t + 2);
    P8_WAIT_V(6); P8_BAR; P8_MMA(1, 1, At, B1); P8_BAR;
    P8_LDB(B0, 1, 0); P8_SCHED; P8_LDA(At, 1, 0); P8_STAGE_A(P8_SA(0, 1), A, 128, t + 2);
    P8_WAIT_L(8); P8_BAR; P8_WAIT_L(0); P8_MMA(0, 0, At, B0); P8_BAR; P8_SCHED;
    P8_LDB(B1, 1, 1); P8_STAGE_B(P8_SB(1, 0), Bt, 0, t + 3);
    P8_BAR; P8_WAIT_L(0); P8_MMA(0, 1, At, B1); P8_BAR;
    P8_LDA(At, 1, 1); P8_STAGE_A(P8_SA(1, 0), A, 0, t + 3);
    P8_BAR; P8_WAIT_L(0); P8_MMA(1, 0, At, B0); P8_BAR; P8_SCHED;
    P8_STAGE_B(P8_SB(1, 1), Bt, 128, t + 3);
    P8_WAIT_V(6); P8_BAR; P8_MMA(1, 1, At, B1); P8_BAR;
  }
  { P8_LDB(B0, 0, 0); P8_LDA(At, 0, 0); P8_STAGE_A(P8_SA(1, 1), A, 128, nt - 1);
    P8_BAR; P8_WAIT_L(0); P8_MMA(0, 0, At, B0); P8_BAR;
    P8_LDB(B1, 0, 1); P8_BAR; P8_WAIT_L(0); P8_MMA(0, 1, At, B1); P8_BAR;
    P8_LDA(At, 0, 1); P8_WAIT_V(4); P8_BAR; P8_WAIT_L(0); P8_MMA(1, 0, At, B0); P8_MMA(1, 1, At, B1); P8_BAR; }
  { P8_LDB(B0, 1, 0); P8_LDA(At, 1, 0); P8_WAIT_V(2); P8_BAR; P8_WAIT_L(0); P8_MMA(0, 0, At, B0); P8_BAR;
    P8_LDB(B1, 1, 1); P8_WAIT_V(0); P8_BAR; P8_WAIT_L(0); P8_MMA(0, 1, At, B1); P8_BAR;
    P8_LDA(At, 1, 1); P8_BAR; P8_WAIT_L(0); P8_MMA(1, 0, At, B0); P8_MMA(1, 1, At, B1); P8_BAR; }
  if (wr == 0) P8_BAR;
}
DEVI void gemm8p_prime(const u16* __restrict__ A, int lda, const u16* __restrict__ Bt, int ldb, char* smem) {
  u16* shm = (u16*)smem;
  const int tid = tidx();
  int sr0, sc0, sr1, sc1;
  p8_stage_rc(tid * 16, sr0, sc0);
  p8_stage_rc(tid * 16 + 8192, sr1, sc1);
  const unsigned oa0 = (unsigned)(sr0 * lda + sc0) * 2u, oa1 = (unsigned)(sr1 * lda + sc1) * 2u;
  P8_STAGE_B(P8_SB(0, 0), Bt, 0, 0); P8_STAGE_A(P8_SA(0, 0), A, 0, 0);
  P8_STAGE_B(P8_SB(0, 1), Bt, 128, 0); P8_STAGE_A(P8_SA(0, 1), A, 128, 0);
}

DEVI int dst_row(int kind, int c) {
  if (kind == 0) return c;
  if (kind == 1) return 32 * (c >> 4) + (c & 15);
  if (kind == 2) return 32 * (c >> 4) + 16 + (c & 15);
  if (kind == 3) return c < 928 ? c : (c < 1952 ? 1024 + (c - 928) : 2048 + (c - 1952));
  const int h = c >> 7, r = c & 127;
  return r < 64 ? h * 64 + r : 512 + h * 64 + (r - 64);
}
DEVI void transpose_tile(const float* __restrict__ src, int Nsrc, int ldd, int k0, int c0, int ncol, u16* __restrict__ dst, int kind,
                         char* smem) {
  float* sm = (float*)smem;
  const int tid = tidx();
  float4 v[8];
#pragma unroll
  for (int ps = 0; ps < 8; ++ps) {
    const int q = tid + ps * 512;
    const int cc = ((q & 7) + 8 * ((q >> 5) & 3)) * 4, r = (q >> 7) * 4 + ((q >> 3) & 3);
    v[ps] = ld_nt4(src + (size_t)(k0 + r) * Nsrc + c0 + min(cc, ncol - 4));
  }
#pragma unroll
  for (int ps = 0; ps < 8; ++ps) {
    const int q = tid + ps * 512;
    const int cc = ((q & 7) + 8 * ((q >> 5) & 3)) * 4, r = (q >> 7) * 4 + ((q >> 3) & 3);
    sm[r * 129 + cc + 0] = v[ps].x; sm[r * 129 + cc + 1] = v[ps].y; sm[r * 129 + cc + 2] = v[ps].z; sm[r * 129 + cc + 3] = v[ps].w;
  }
  __syncthreads();
#pragma unroll
  for (int ps = 0; ps < 4; ++ps) {
    const int q = tid + ps * 512;
    const int kk = ((q & 3) + 4 * ((q >> 5) & 3)) * 8, rr = (q >> 7) * 8 + ((q >> 2) & 7);
    if (rr < ncol) {
      uint4 o;
      o.x = pk2(sm[(kk + 0) * 129 + rr], sm[(kk + 1) * 129 + rr]);
      o.y = pk2(sm[(kk + 2) * 129 + rr], sm[(kk + 3) * 129 + rr]);
      o.z = pk2(sm[(kk + 4) * 129 + rr], sm[(kk + 5) * 129 + rr]);
      o.w = pk2(sm[(kk + 6) * 129 + rr], sm[(kk + 7) * 129 + rr]);
      {
        typedef unsigned v4u_t __attribute__((ext_vector_type(4)));
        v4u_t ov = {o.x, o.y, o.z, o.w};
        __builtin_nontemporal_store(ov, (v4u_t*)(dst + (size_t)dst_row(kind, c0 + rr) * ldd + k0 + kk));
      }
    }
  }
  __syncthreads();
}

constexpr int PREP_PER_LAYER = 176 * 6 + 192 + 18 + 16 + 32 + 64;
constexpr int PREP_DEFER = 512;
DEVI void prep_convert_task(const Params& p, char* ws, int task, char* smem) {
  constexpr int PER_LAYER = PREP_PER_LAYER;
    const int l = task / PER_LAYER;
    int r = task % PER_LAYER;
    const float* src; int K, Nsrc; u16* dst; int kind;
    if (r < 176 * 6) {
      const int which = r / 176; r %= 176;
      const int f = which / 3, w = which % 3;
      const int inidx = (f == 0 ? 9 : 22) + w;
      if (w < 2) { K = 1024; Nsrc = FF; src = p.in[inidx] + (size_t)l * 1024 * FF; dst = (u16*)(ws + OFF_WGU + (l * 2 + f) * SZ_WGU); kind = 1 + w; }
      else       { K = FF; Nsrc = 1024; src = p.in[inidx] + (size_t)l * 1024 * FF; dst = (u16*)(ws + OFF_WD + (l * 2 + f) * SZ_WD); kind = 0; }
    } else {
      r -= 176 * 6;
      if (r < 192) { K = 1024; Nsrc = 2976; src = p.in[13] + (size_t)l * 1024 * 2976; dst = (u16*)(ws + OFF_WIN + l * SZ_WIN); kind = 3; }
      else if ((r -= 192) < 18) { K = 384; Nsrc = 768; src = p.in[16] + (size_t)l * 384 * 768; dst = (u16*)(ws + OFF_WUQ + l * SZ_WUQ); kind = 0; }
      else if ((r -= 18) < 16) { K = 256; Nsrc = 1024; src = p.in[18] + (size_t)l * 256 * 1024; dst = (u16*)(ws + OFF_WUKV + l * SZ_WUKV); kind = 4; }
      else if ((r -= 16) < 32) { K = 512; Nsrc = 1024; src = p.in[19] + (size_t)l * 512 * 1024; dst = (u16*)(ws + OFF_WAP + l * SZ_WAP); kind = 0; }
      else { r -= 32; K = 1024; Nsrc = 1024; src = p.in[20] + (size_t)l * 1024 * 1024; dst = (u16*)(ws + OFF_WOUT + l * SZ_WOUT); kind = 0; }
    }
    const int nkt = K / 128;
    const int ct = r / nkt, kt = r % nkt;
    const int c0 = ct * 128;
    const int ncol = min(128, Nsrc - c0);
    transpose_tile(src, Nsrc, (kind == 1 || kind == 2) ? LDW : K, kt * 128, c0, ncol, dst, kind, smem);
}

DEVI void phase_prep(const Params& p, char* smem) {
  const int tid = tidx();
  char* ws = PWS;
  {
    const int ntask = gridDim.x == 256 ? 2 * PREP_PER_LAYER - 2 * PREP_DEFER : 2 * PREP_PER_LAYER;
    for (int task = blockIdx.x; task < ntask; task += gridDim.x) prep_convert_task(p, ws, task, smem);
  }
  for (int i = blockIdx.x * NT + tid; i < 2 * 96 * 1024 / 8; i += gridDim.x * NT) {
    const int l = i / (96 * 128), e = i % (96 * 128);
    unsigned z = 0; asm volatile("" : "+v"(z));
    *(uint4*)(ws + OFF_WIN + l * SZ_WIN + (size_t)928 * 1024 * 2 + (size_t)e * 16) = uint4{z, z, z, z};
  }
  {
    float* sc = (float*)smem;
    float* part = sc + 5 * 1024;
    __syncthreads();
    for (int i = tid; i < 5 * 1024; i += NT) {
      const int rr = i >> 10, k = i & 1023;
      sc[i] = siluf(rr == 0 ? p.in[5][k] : p.in[4][(rr - 1) * 1024 + k]);
    }
    __syncthreads();
    const int wid = tid >> 6, lane = tid & 63, half = lane >> 5, q = min(lane & 31, 17);
    for (int task = blockIdx.x; task < 256; task += gridDim.x) {
      const int l = task >> 7, c0 = (task & 127) * 72;
      const float* w = p.in[6] + (size_t)l * 1024 * NMODC + (size_t)(wid * 128 + half) * NMODC + c0 + q * 4;
      float4 a0 = {0, 0, 0, 0}, a1 = a0, a2 = a0, a3 = a0, a4 = a0;
#pragma unroll 1
      for (int ib = 0; ib < 4; ++ib) {
        float4 wv[16];
#pragma unroll
        for (int j = 0; j < 16; ++j) wv[j] = ld_nt4(w + (size_t)(2 * (ib * 16 + j)) * NMODC);
        __builtin_amdgcn_sched_barrier(0);
#pragma unroll
        for (int j = 0; j < 16; ++j) {
          const int k = wid * 128 + 2 * (ib * 16 + j) + half;
          const float s0 = sc[k], s1 = sc[1024 + k], s2 = sc[2048 + k], s3 = sc[3072 + k], s4 = sc[4096 + k];
          a0.x += s0 * wv[j].x; a0.y += s0 * wv[j].y; a0.z += s0 * wv[j].z; a0.w += s0 * wv[j].w;
          a1.x += s1 * wv[j].x; a1.y += s1 * wv[j].y; a1.z += s1 * wv[j].z; a1.w += s1 * wv[j].w;
          a2.x += s2 * wv[j].x; a2.y += s2 * wv[j].y; a2.z += s2 * wv[j].z; a2.w += s2 * wv[j].w;
          a3.x += s3 * wv[j].x; a3.y += s3 * wv[j].y; a3.z += s3 * wv[j].z; a3.w += s3 * wv[j].w;
          a4.x += s4 * wv[j].x; a4.y += s4 * wv[j].y; a4.z += s4 * wv[j].z; a4.w += s4 * wv[j].w;
        }
        __builtin_amdgcn_sched_barrier(0);
      }
#define MOD_RED(A) A.x += shx(A.x, 32, lane); A.y += shx(A.y, 32, lane); A.z += shx(A.z, 32, lane); A.w += shx(A.w, 32, lane);
      MOD_RED(a0) MOD_RED(a1) MOD_RED(a2) MOD_RED(a3) MOD_RED(a4)
#undef MOD_RED
      if (lane < 18) {
        float* pp = part + wid * 360 + lane * 4;
        *(float4*)(pp) = a0; *(float4*)(pp + 72) = a1; *(float4*)(pp + 144) = a2; *(float4*)(pp + 216) = a3; *(float4*)(pp + 288) = a4;
      }
      __syncthreads();
      if (tid < 360) {
        const int rr = tid / 72, c = c0 + tid % 72;
        float s = p.in[7][l * NMODC + c];
#pragma unroll
        for (int w8 = 0; w8 < 8; ++w8) s += part[w8 * 360 + tid];
        ((float*)(ws + OFF_MOD))[(size_t)(l * 5 + rr) * NMODC + c] = s;
      }
      __syncthreads();
    }
  }
  {
    u16* cl = (u16*)(ws + OFF_CSLAT);
    for (int i = blockIdx.x * NT + tid; i < 2048 * 1024; i += gridDim.x * NT) {
      const int r = i >> 10, n = i & 1023;
      const int m = ((r & 1023) * n) & 1023;
      const float a = (float)m * (1.f / 512.f);
      cl[i] = f2bf(r < 1024 ? cospif(a) : sinpif(a));
    }
    u16* cc = (u16*)(ws + OFF_CSCTX);
    for (int i = blockIdx.x * NT + tid; i < 512 * 256; i += gridDim.x * NT) {
      const int r = i >> 8, n = i & 255;
      const int m = ((r & 255) * n) & 255;
      const float a = (float)m * (1.f / 128.f);
      cc[i] = f2bf(r < 256 ? cospif(a) : sinpif(a));
    }
    float* rt = (float*)(ws + OFF_ROPE);
    for (int i = blockIdx.x * NT + tid; i < 1024 * 16; i += gridDim.x * NT) {
      const int pos = i >> 4, a = (i >> 3) & 1, f = i & 7;
      const float inv = powf(10000.0f, -(float)(2 * f) / 16.0f);
      const float ang = (float)(a == 0 ? (pos >> 6) : (pos & 63)) * inv;
      rt[pos * 32 + a * 8 + f] = cosf(ang);
      rt[pos * 32 + 16 + a * 8 + f] = sinf(ang);
    }
  }
  {
    float* tb = (float*)smem;
    float* w4s = tb + 128;
    __syncthreads();
    if (tid < 64) { tb[tid] = cospif((float)tid * (1.f / 32.f)); tb[64 + tid] = sinpif((float)tid * (1.f / 32.f)); }
    for (int task = blockIdx.x; task < 256; task += gridDim.x) {
      const int l = task >> 7, g = (task >> 5) & 3, j0 = (task & 31) * 32;
      __syncthreads();
      for (int i = tid; i < 2048; i += NT) w4s[i] = p.in[14][(size_t)l * 256 * 1024 + (size_t)(g * 64 + (i >> 5)) * 1024 + j0 + (i & 31)];
      __syncthreads();
      const int j = tid & 31, kq = tid >> 5;
      u16* o = (u16*)(ws + OFF_W4F + l * SZ_W4F) + (size_t)(j0 + j) * 512 + g * 64 + kq * 4;
#pragma unroll 1
      for (int cs = 0; cs < 2; ++cs) {
        float a[4];
#pragma unroll
        for (int kk = 0; kk < 4; ++kk) a[kk] = 0.f;
#pragma unroll 4
        for (int k2 = 0; k2 < 64; ++k2) {
          const float wv = w4s[k2 * 32 + j];
#pragma unroll
          for (int kk = 0; kk < 4; ++kk) a[kk] += tb[cs * 64 + (((kq * 4 + kk) * k2) & 63)] * wv;
        }
        const float sg = cs ? -1.f : 1.f;
        uint2 ov;
        ov.x = pk2(sg * a[0], sg * a[1]); ov.y = pk2(sg * a[2], sg * a[3]);
        *(uint2*)(o + cs * 256) = ov;
      }
    }
    __syncthreads();
  }
}

DEVI const float* x_row(const Params& p, bool from_input, int t) {
  if (from_input) return t < TCTX ? p.in[0] + (size_t)t * D : p.in[1] + (size_t)(t - TCTX) * D;
  return (const float*)(PWS + OFF_X) + (size_t)t * D;
}

DEVI void phase_norm(const Params& p, int l, int which, bool from_input) {
  const int lane = tidx() & 63, gw = blockIdx.x * NWV + (tidx() >> 6), nw = gridDim.x * NWV;
  const float* gain = p.in[which == 0 ? 8 : (which == 1 ? 12 : 21)] + l * D;
  const float* mod = (const float*)(PWS + OFF_MOD) + (size_t)l * 5 * NMODC;
  u16* h = (u16*)(PWS + OFF_H);
  for (int t = gw; t < T; t += nw) {
    const float* xr = x_row(p, from_input, t);
    const float* m = mod + (size_t)mod_row(t) * NMODC + which * 3 * D;
    float4 v[4];
    float ss = 0.f;
#pragma unroll
    for (int i = 0; i < 4; ++i) {
      v[i] = *(const float4*)(xr + i * 256 + lane * 4);
      ss += v[i].x * v[i].x + v[i].y * v[i].y + v[i].z * v[i].z + v[i].w * v[i].w;
    }
    ss = wave_sum(ss, lane);
    const float rs = rsqrtf(ss * (1.f / D) + EPS);
#pragma unroll
    for (int i = 0; i < 4; ++i) {
      const int c = i * 256 + lane * 4;
      const float4 g = *(const float4*)(gain + c), sh = *(const float4*)(m + c), sc = *(const float4*)(m + D + c);
      st_bf4(h + (size_t)t * LDH + c, v[i].x * rs * g.x * (1.f + sc.x) + sh.x, v[i].y * rs * g.y * (1.f + sc.y) + sh.y,
             v[i].z * rs * g.z * (1.f + sc.z) + sh.z, v[i].w * rs * g.w * (1.f + sc.w) + sh.w);
    }
  }
}

DEVI void phase_cachecopy(const Params& p, int l) {
  const int lane = tidx() & 63, gw = blockIdx.x * NWV + (tidx() >> 6), nw = gridDim.x * NWV;
  u16* kc = (u16*)(PWS + OFF_KEYCKV);
  u16* kr = (u16*)(PWS + OFF_KEYROPE);
  for (int j = gw; j < 2048; j += nw) {
    const int b = j >> 9, n = j & 511;
    const int keyrow = TCTX + b * 1536 + 1024 + n;
    const float4 cv = *(const float4*)(p.in[2] + ((size_t)(b * 2 + l) * 512 + n) * 256 + lane * 4);
    st_bf4(kc + (size_t)keyrow * 256 + lane * 4, cv.x, cv.y, cv.z, cv.w);
    if (lane < 32) kr[(size_t)keyrow * 32 + lane] = f2bf(p.in[3][((size_t)(b * 2 + l) * 512 + n) * 32 + lane]);
  }
}

DEVI void phase_final(const Params& p) {
  const int lane = tidx() & 63, gw = blockIdx.x * NWV + (tidx() >> 6), nw = gridDim.x * NWV;
  const float* gain = p.in[25];
  for (int t = gw; t < T; t += nw) {
    const float* xr = (const float*)(PWS + OFF_X) + (size_t)t * D;
    float4 v[4];
    float ss = 0.f;
#pragma unroll
    for (int i = 0; i < 4; ++i) {
      v[i] = *(const float4*)(xr + i * 256 + lane * 4);
      ss += v[i].x * v[i].x + v[i].y * v[i].y + v[i].z * v[i].z + v[i].w * v[i].w;
    }
    ss = wave_sum(ss, lane);
    const float rs = rsqrtf(ss * (1.f / D) + EPS);
#pragma unroll
    for (int i = 0; i < 4; ++i) {
      const int c = i * 256 + lane * 4;
      const float4 g = *(const float4*)(gain + c);
      float4 o = {v[i].x * rs * g.x, v[i].y * rs * g.y, v[i].z * rs * g.z, v[i].w * rs * g.w};
      *(float4*)(p.out + (size_t)t * D + c) = o;
    }
  }
}

DEVI void phase_gu(const Params& p, int l, int f, char* smem) {
  char* ws = PWS;
  const u16* A = (const u16*)(ws + OFF_H);
  const u16* W = (const u16*)(ws + OFF_WGU + (l * 2 + f) * SZ_WGU);
  u16* act = (u16*)(ws + OFF_ACT);
  constexpr int nM = 32, nN = 22;
  for (int tile = blockIdx.x; tile < nM * nN; tile += gridDim.x) {
    int tm, tn; tile_mn(tile, nM, nN, tm, tn);
    f32x4 acc[2][2][4][2];
#pragma unroll
    for (int ai = 0; ai < 2; ++ai)
#pragma unroll
      for (int bj = 0; bj < 2; ++bj)
#pragma unroll
        for (int m = 0; m < 4; ++m)
#pragma unroll
          for (int n = 0; n < 2; ++n) acc[ai][bj][m][n] = f32x4{0.f, 0.f, 0.f, 0.f};
    gemm8p_tile(acc, A + (size_t)tm * 256 * LDH, LDH, W + (size_t)tn * 256 * LDW, LDW, D, smem, tile != (int)blockIdx.x);
    {
      const int nxt = tile + gridDim.x;
      if (nxt < nM * nN) { int tm2, tn2; tile_mn(nxt, nM, nN, tm2, tn2); gemm8p_prime(A + (size_t)tm2 * 256 * LDH, LDH, W + (size_t)tn2 * 256 * LDW, LDW, smem); }
    }
    const int tid2 = tidx(), wid = tid2 >> 6, lane = tid2 & 63, wr = wid >> 2, wc = wid & 3, fr = lane & 15, fq = lane >> 4;
#pragma unroll
    for (int ai = 0; ai < 2; ++ai)
#pragma unroll
      for (int m = 0; m < 4; ++m) {
        const int row = tm * 256 + ai * 128 + wr * 64 + m * 16 + fr;
#pragma unroll
        for (int bj = 0; bj < 2; ++bj) {
          const int ffc = (tn * 256 + bj * 128 + wc * 32) / 2 + fq * 4;
          const f32x4 g = acc[ai][bj][m][0], u = acc[ai][bj][m][1];
          st_bf4(act + (size_t)row * FF + ffc, siluf(g[0]) * u[0], siluf(g[1]) * u[1], siluf(g[2]) * u[2], siluf(g[3]) * u[3]);
        }
      }
  }
  if (l == 0 && gridDim.x == 256 && blockIdx.x >= 192) {
    __syncthreads();
    const int first = 2 * PREP_PER_LAYER - 2 * PREP_DEFER + (f == 0 ? 0 : PREP_DEFER), count = PREP_DEFER;
    for (int t = blockIdx.x - 192; t < count; t += 64) prep_convert_task(p, ws, first + t, smem);
  }
}

DEVI void phase_resid(const Params& p, const u16* A, int lda, int K, const u16* W, int l, int gslot, float coef, bool from_input, char* smem) {
  char* ws = PWS;
  const float* mod = (const float*)(ws + OFF_MOD) + (size_t)l * 5 * NMODC + gslot * D;
  float* xo = (float*)(ws + OFF_X);
  const int tid = tidx(), wid = tid >> 6, lane = tid & 63, wr = wid >> 1, wc = wid & 1, fr = lane & 15, fq = lane >> 4;
  constexpr int nM = 32, nN = 8;
  auto get = [&](int tile) { int tm, tn; const bool ok = tile_xcd(tile, nM, nN, tm, tn); return TileDesc{A + (size_t)tm * TM * lda, W + (size_t)tn * 128 * K, lda, K, ok ? K / BK : 0}; };
  auto epi = [&](int tile, f32x4 (&acc)[4][4]) {
    int tm, tn; tile_xcd(tile, nM, nN, tm, tn);
#pragma unroll
    for (int m = 0; m < 4; ++m) {
      const int row = tm * TM + wr * 64 + m * 16 + fr;
      const float* xs = x_row(p, from_input, row);
      const float* gv = mod + (size_t)mod_row(row) * NMODC;
#pragma unroll
      for (int n = 0; n < 4; ++n) {
        const int col = tn * 128 + wc * 64 + n * 16 + fq * 4;
        const float4 xv = *(const float4*)(xs + col), g = *(const float4*)(gv + col);
        float4 o = {xv.x + coef * g.x * acc[m][n][0], xv.y + coef * g.y * acc[m][n][1], xv.z + coef * g.z * acc[m][n][2], xv.w + coef * g.w * acc[m][n][3]};
        *(float4*)(xo + (size_t)row * D + col) = o;
      }
    }
  };
  gemm_stream(nM * nN, get, epi, smem);
}

DEVI void phase_win(const Params& p, int l, char* smem) {
  char* ws = PWS;
  const u16* H = (const u16*)(ws + OFF_H);
  const u16* W = (const u16*)(ws + OFF_WIN + l * SZ_WIN);
  const int tid = tidx(), wid = tid >> 6, lane = tid & 63, wr = wid >> 1, wc = wid & 1, fr = lane & 15, fq = lane >> 4;
  constexpr int NF = 64, nM = 32, nN = 22;
  auto get = [&](int tile) {
    if (tile < NF) return TileDesc{W, H + (size_t)tile * 128 * LDH, D, LDH, D / BK};
    int tm, tn; tile_mn(tile - NF, nM, nN, tm, tn);
    return TileDesc{H + (size_t)tm * TM * LDH, W + (size_t)(tn + 2) * 128 * D, LDH, D, D / BK};
  };
  auto epi = [&](int tile, f32x4 (&acc)[4][4]) {
    if (tile < NF) {
      u16* finT = (u16*)(ws + OFF_FINT);
      const int t0 = tile * 128;
      int tb, np;
      if (t0 < TCTX) { tb = t0 & ~255; np = 256; } else { tb = TCTX + ((t0 - TCTX) & ~1023); np = 1024; }
#pragma unroll
      for (int m = 0; m < 4; ++m) {
        const int ch = wr * 64 + m * 16 + fr;
#pragma unroll
        for (int n = 0; n < 4; ++n) {
          const int pos = t0 - tb + wc * 64 + n * 16 + fq * 4;
          st_bf4(finT + (size_t)tb * 256 + (size_t)ch * np + pos, acc[m][n][0], acc[m][n][1], acc[m][n][2], acc[m][n][3]);
        }
      }
    } else {
      int tm, tn; tile_mn(tile - NF, nM, nN, tm, tn);
      tn += 2;
      const float* qg = p.in[15] + l * 384;
      const float* kg = p.in[17] + l * 256;
      const float* rt = (const float*)(ws + OFF_ROPE);
#pragma unroll
      for (int m = 0; m < 4; ++m) {
        const int row = tm * TM + wr * 64 + m * 16 + fr;
        int keyrow, npos = 0;
        if (row < TCTX) keyrow = row;
        else { const int b = (row - TCTX) >> 10; npos = (row - TCTX) & 1023; keyrow = TCTX + b * 1536 + npos; }
        float ss = 0.f;
#pragma unroll
        for (int n = 0; n < 4; ++n) {
          const int c = wc * 64 + n * 16 + fq * 4;
          const f32x4 a = acc[m][n];
          if (tn < 5) {
            const int col = (tn - 2) * 128 + c;
            const float4 g = *(const float4*)(qg + col);
            ss += a[0] * a[0] + a[1] * a[1] + a[2] * a[2] + a[3] * a[3];
            st_bf4((u16*)(ws + OFF_QN) + (size_t)row * 384 + col, a[0] * g.x, a[1] * g.y, a[2] * g.z, a[3] * g.w);
          } else if (tn < 7) {
            const int col = (tn - 5) * 128 + c;
            const float4 g = *(const float4*)(kg + col);
            ss += a[0] * a[0] + a[1] * a[1] + a[2] * a[2] + a[3] * a[3];
            const float4 v = {a[0] * g.x, a[1] * g.y, a[2] * g.z, a[3] * g.w};
            st_bf4((u16*)(ws + OFF_KEYCKV) + (size_t)keyrow * 256 + col, v.x, v.y, v.z, v.w);
            if (row < TCTX) {
              const int b = row >> 8, nn = row & 255;
              *(float4*)(p.out + 8388608 + ((size_t)(b * 2 + l) * 256 + nn) * 256 + col) = v;
            }
          } else if (tn == 7) {
            if (c < 32) {
              if (row < TCTX) {
                const int b = row >> 8, nn = row & 255;
                *(float4*)(p.out + 10485760 + ((size_t)(b * 2 + l) * 256 + nn) * 32 + c) = float4{a[0], a[1], a[2], a[3]};
                st_bf4((u16*)(ws + OFF_KEYROPE) + (size_t)keyrow * 32 + c, a[0], a[1], a[2], a[3]);
              } else {
                f32x4 pr, o;
#pragma unroll
                for (int j = 0; j < 4; ++j) pr[j] = shx(a[j], 32, lane);
#pragma unroll
                for (int j = 0; j < 4; ++j) {
                  const int f = (fq & 1) * 4 + j;
                  const float cs = rt[npos * 32 + n * 8 + f], sn = rt[npos * 32 + 16 + n * 8 + f];
                  o[j] = (fq < 2) ? a[j] * cs - pr[j] * sn : a[j] * cs + pr[j] * sn;
                }
                st_bf4((u16*)(ws + OFF_KEYROPE) + (size_t)keyrow * 32 + c, o[0], o[1], o[2], o[3]);
              }
            }
          } else if (tn < 16) {
            st_bf4((u16*)(ws + OFF_SGF) + (size_t)row * D + (tn - 8) * 128 + c, sigmf(a[0]), sigmf(a[1]), sigmf(a[2]), sigmf(a[3]));
          } else {
            st_bf4((u16*)(ws + OFF_SGA) + (size_t)row * D + (tn - 16) * 128 + c, sigmf(a[0]), sigmf(a[1]), sigmf(a[2]), sigmf(a[3]));
          }
        }
        if (tn < 7) {
          ss += shx(ss, 16, lane);
          ss += shx(ss, 32, lane);
          if (fq == 0) {
            if (tn < 5) ((float*)(ws + OFF_PQ))[(size_t)row * 8 + (tn - 2) * 2 + wc] = ss;
            else        ((float*)(ws + OFF_PK))[(size_t)row * 4 + (tn - 5) * 2 + wc] = ss;
          }
        }
      }
    }
  };
  gemm_stream(NF + nM * nN, get, epi, smem);
}

DEVI void phase_qkv_dft(const Params& p, int l, char* smem) {
  char* ws = PWS;
  const int tid = tidx(), wid = tid >> 6, lane = tid & 63, wr = wid >> 1, wc = wid & 1, fr = lane & 15, fq = lane >> 4;
  constexpr int NDL = 4 * 8 * 2, NDC = 16 * 2 * 2, NQ = 32 * 6, NKN = 40 * 4, NVT = 2 * 80;
  constexpr int E0 = NDL, E1 = E0 + NDC, E2 = E1 + NQ, E3 = E2 + NKN, E4 = E3 + NVT;
  const float* rt = (const float*)(ws + OFF_ROPE);
  const float* pq = (const float*)(ws + OFF_PQ);
  const float* pk = (const float*)(ws + OFF_PK);
  auto rs_q = [&](int row) {
    const float4 a = *(const float4*)(pq + (size_t)row * 8);
    const float2 b2 = *(const float2*)(pq + (size_t)row * 8 + 4);
    return rsqrtf((a.x + a.y + a.z + a.w + b2.x + b2.y) * (1.f / 384.f) + EPS);
  };
  auto rs_key = [&](int keyrow) {
    int tok;
    if (keyrow < TCTX) tok = keyrow;
    else { const int r = keyrow - TCTX, b = r / 1536, n = r - b * 1536; if (n >= 1024) return 1.f; tok = TCTX + b * 1024 + n; }
    const float4 a = *(const float4*)(pk + (size_t)tok * 4);
    return rsqrtf((a.x + a.y + a.z + a.w) * (1.f / 256.f) + EPS);
  };
  {
    const int gw = blockIdx.x * NWV + wid, nw = gridDim.x * NWV;
    for (int t = gw; t < TCTX; t += nw) {
      const float rs = rs_key(t);
      const int b = t >> 8, nn = t & 255;
      float4* o = (float4*)(p.out + 8388608 + ((size_t)(b * 2 + l) * 256 + nn) * 256 + lane * 4);
      float4 v = *o;
      v.x *= rs; v.y *= rs; v.z *= rs; v.w *= rs;
      *o = v;
    }
  }
  auto remap = [&](int idx) -> int {
    if (gridDim.x != 256) return idx < E4 ? idx : -1;
    const int b = idx & 255, t = idx >> 8;
    if (b < 64) return t == 0 ? b : -1;
    if (t >= 3) return -1;
    int j = (b - 64) + t * 192;
    if (j < 192) return E1 + j;
    j -= 192;
    if (j < 64) return E0 + j;
    return E2 + (j - 64);
  };
  auto get = [&](int idx) {
    const int tile = remap(idx);
    if (tile < 0) return TileDesc{nullptr, nullptr, 0, 0, 0};
    if (tile < E0) {
      const int b = tile >> 4, r = tile & 15, tm = r >> 1, tn = r & 1;
      return TileDesc{(const u16*)(ws + OFF_CSLAT) + (size_t)tm * TM * 1024,
                      (const u16*)(ws + OFF_FINT) + (size_t)(TCTX + b * 1024) * 256 + (size_t)tn * 128 * 1024, 1024, 1024, 16};
    } else if (tile < E1) {
      const int id = tile - E0, b = id >> 2, r = id & 3, tm = r >> 1, tn = r & 1;
      return TileDesc{(const u16*)(ws + OFF_CSCTX) + (size_t)tm * TM * 256,
                      (const u16*)(ws + OFF_FINT) + (size_t)(b * 256) * 256 + (size_t)tn * 128 * 256, 256, 256, 4};
    } else if (tile < E2) {
      int tm, tn; tile_mn(tile - E1, 32, 6, tm, tn);
      return TileDesc{(const u16*)(ws + OFF_QN) + (size_t)tm * TM * 384, (const u16*)(ws + OFF_WUQ + l * SZ_WUQ) + (size_t)tn * 128 * 384, 384, 384, 6};
    } else if (tile < E3) {
      int tm, tn; tile_mn(tile - E2, 40, 4, tm, tn);
      return TileDesc{(const u16*)(ws + OFF_KEYCKV) + (size_t)tm * TM * 256, (const u16*)(ws + OFF_WUKV + l * SZ_WUKV) + (size_t)tn * 128 * 256, 256, 256, 4};
    } else {
      const int id = tile - E3, vh = id / 80, kt = id % 80;
      return TileDesc{(const u16*)(ws + OFF_WUKV + l * SZ_WUKV) + (size_t)(512 + vh * 256) * 256, (const u16*)(ws + OFF_KEYCKV) + (size_t)kt * 128 * 256, 256, 256, 4};
    }
  };
  auto epi = [&](int idx, f32x4 (&acc)[4][4]) {
    const int tile = remap(idx);
    if (tile < E0) {
      const int b = tile >> 4, r = tile & 15, tm = r >> 1, tn = r & 1;
      u16* ycs = (u16*)(ws + OFF_YCS);
#pragma unroll
      for (int m = 0; m < 4; ++m) {
        const int rr = tm * TM + wr * 64 + m * 16 + fr;
        const size_t tok = TCTX + b * 1024 + (rr & 1023);
#pragma unroll
        for (int n = 0; n < 4; ++n) {
          const int col = (rr >> 10) * 256 + tn * 128 + wc * 64 + n * 16 + fq * 4;
          const float s = 1.f / 256.f;
          st_bf4(ycs + tok * 512 + col, acc[m][n][0] * s, acc[m][n][1] * s, acc[m][n][2] * s, acc[m][n][3] * s);
        }
      }
    } else if (tile < E1) {
      const int id = tile - E0, b = id >> 2, r = id & 3, tm = r >> 1, tn = r & 1;
      u16* ycs = (u16*)(ws + OFF_YCS);
#pragma unroll
      for (int m = 0; m < 4; ++m) {
        const int rr = tm * TM + wr * 64 + m * 16 + fr;
        const size_t tok = b * 256 + (rr & 255);
#pragma unroll
        for (int n = 0; n < 4; ++n) {
          const int col = (rr >> 8) * 256 + tn * 128 + wc * 64 + n * 16 + fq * 4;
          const float s = 1.f / 128.f;
          st_bf4(ycs + tok * 512 + col, acc[m][n][0] * s, acc[m][n][1] * s, acc[m][n][2] * s, acc[m][n][3] * s);
        }
      }
    } else if (tile < E2) {
      int tm, tn; tile_mn(tile - E1, 32, 6, tm, tn);
      u16* qf = (u16*)(ws + OFF_QF);
#pragma unroll
      for (int m = 0; m < 4; ++m) {
        const int row = tm * TM + wr * 64 + m * 16 + fr;
        const float rsq = rs_q(row);
#pragma unroll
        for (int n = 0; n < 4; ++n) {
          const int c0 = tn * 128 + wc * 64 + n * 16;
          const int off = c0 % 96;
          f32x4 a = acc[m][n] * rsq;
          if (off >= 64 && tm >= 16) {
            const int ax = (off - 64) >> 4;
            const int npos = (row - TCTX) & 1023;
            f32x4 pr;
#pragma unroll
            for (int j = 0; j < 4; ++j) pr[j] = shx(a[j], 32, lane);
#pragma unroll
            for (int j = 0; j < 4; ++j) {
              const int f = (fq & 1) * 4 + j;
              const float c = rt[npos * 32 + ax * 8 + f], s = rt[npos * 32 + 16 + ax * 8 + f];
              a[j] = (fq < 2) ? a[j] * c - pr[j] * s : a[j] * c + pr[j] * s;
            }
          }
          st_bf4(qf + (size_t)row * 768 + c0 + fq * 4, a[0], a[1], a[2], a[3]);
        }
      }
    } else if (tile < E3) {
      int tm, tn; tile_mn(tile - E2, 40, 4, tm, tn);
      u16* kn = (u16*)(ws + OFF_KNOPE);
#pragma unroll
      for (int m = 0; m < 4; ++m) {
        const int row = tm * TM + wr * 64 + m * 16 + fr;
        const float rsk = rs_key(row);
#pragma unroll
        for (int n = 0; n < 4; ++n)
          st_bf4(kn + (size_t)row * 512 + tn * 128 + wc * 64 + n * 16 + fq * 4, acc[m][n][0] * rsk, acc[m][n][1] * rsk, acc[m][n][2] * rsk, acc[m][n][3] * rsk);
      }
    } else {
      const int id = tile - E3, vh = id / 80, kt = id % 80;
      u16* vt = (u16*)(ws + OFF_VT);
      const int k0 = kt * 128;
      int kb, M;
      if (k0 < TCTX) { kb = k0 & ~255; M = 256; } else { kb = TCTX + ((k0 - TCTX) / 1536) * 1536; M = 1536; }
      float rk[4][4];
#pragma unroll
      for (int n = 0; n < 4; ++n)
#pragma unroll
        for (int j = 0; j < 4; ++j) rk[n][j] = rs_key(k0 + wc * 64 + n * 16 + fq * 4 + j);
#pragma unroll
      for (int m = 0; m < 4; ++m) {
        const int vc = vh * 256 + wr * 64 + m * 16 + fr;
#pragma unroll
        for (int n = 0; n < 4; ++n) {
          const int kl = k0 - kb + wc * 64 + n * 16 + fq * 4;
          st_bf4(vt + (size_t)kb * 512 + (size_t)vc * M + kl, acc[m][n][0] * rk[n][0], acc[m][n][1] * rk[n][1], acc[m][n][2] * rk[n][2], acc[m][n][3] * rk[n][3]);
        }
      }
    }
  };
  gemm_stream(768, get, epi, smem);
}

constexpr int AT_KN = 0, AT_RP = 16384, AT_VT = 24576, AT_STAGE = 40960;
DEVI void attn_block(const Params& p, int bt, char* smem) {
  const int tid = tidx(), wid = tid >> 6, lane = tid & 63, fr = lane & 15, fq = lane >> 4;
  const int qg = wid & 3, kh = wid >> 2;
  int M, keybase, tokb, h;
  if (bt < 256) { const int b = bt >> 6; h = (bt >> 3) & 7; M = 1536; keybase = TCTX + b * 1536; tokb = TCTX + b * 1024 + (bt & 7) * 128 + qg * 32; }
  else { const int id = bt - 256, b = id >> 4; h = (id >> 1) & 7; M = 256; keybase = b * 256; tokb = b * 256 + (id & 1) * 128 + qg * 32; }
  char* ws = PWS;
  bf16x8 qfrag[2][3];
#pragma unroll
  for (int qt = 0; qt < 2; ++qt) {
    const u16* qf = (const u16*)(ws + OFF_QF) + (size_t)(tokb + qt * 16 + fr) * 768 + h * 96 + fq * 8;
#pragma unroll
    for (int ks = 0; ks < 3; ++ks) qfrag[qt][ks] = *(const bf16x8*)(qf + ks * 32);
  }
  const u16* gk = (const u16*)(ws + OFF_KNOPE) + (size_t)(keybase + (tid >> 3)) * 512 + h * 64 + (((tid & 7) ^ ((tid >> 4) & 7)) * 8);
  const u16* gr = (const u16*)(ws + OFF_KEYROPE) + (size_t)(keybase + (tid >> 2)) * 32 + (((tid & 3) ^ ((-(tid >> 4)) & 3)) * 8);
  const u16* gv = (const u16*)(ws + OFF_VT) + (size_t)keybase * 512 + (size_t)(h * 64 + (tid >> 4)) * M + (((tid & 15) ^ ((tid >> 4) & 15)) * 8);
  auto stage = [&](int kt, int buf) {
    char* s = smem + buf * AT_STAGE + tid * 16;
    const int k0 = kt * 128;
    glds16(gk + (size_t)k0 * 512, s + AT_KN);
    glds16(gk + (size_t)(k0 + 64) * 512, s + AT_KN + 8192);
    glds16(gr + (size_t)k0 * 32, s + AT_RP);
    glds16(gv + k0, s + AT_VT);
    glds16(gv + (size_t)32 * M + k0, s + AT_VT + 8192);
  };
  f32x4 o[2][4];
#pragma unroll
  for (int qt = 0; qt < 2; ++qt)
#pragma unroll
    for (int i = 0; i < 4; ++i) o[qt][i] = f32x4{0.f, 0.f, 0.f, 0.f};
  float mrun[2] = {-1e30f, -1e30f}, lsum[2] = {0.f, 0.f};
  const float sc = 0.10206207261596577f * 1.4426950408889634f;
  const int nt = M >> 7;
  const int kswz = fr >> 1, rswz = (-(fr >> 2)) & 3;
  asm volatile("s_waitcnt vmcnt(0)" ::: "memory");
  stage(0, 0);
  stage(1, 1);
  int buf = 0;
  for (int t = 0; t < nt; ++t) {
    if (t + 1 < nt) asm volatile("s_waitcnt vmcnt(5)" ::: "memory");
    else            asm volatile("s_waitcnt vmcnt(0)" ::: "memory");
    __builtin_amdgcn_s_barrier();
    asm volatile("" ::: "memory");
    if (t + 2 < nt) stage(t + 2, buf >= 1 ? buf - 1 : 2);
    const char* sb = smem + buf * AT_STAGE;
    bf16x8 kf[3][2][2];
#pragma unroll
    for (int ks = 0; ks < 3; ++ks)
#pragma unroll
      for (int s2 = 0; s2 < 2; ++s2)
#pragma unroll
        for (int tt = 0; tt < 2; ++tt) {
          const int kr = (kh * 2 + s2) * 32 + tt * 16 + fr;
          kf[ks][s2][tt] = ks < 2 ? *(const bf16x8*)(sb + AT_KN + kr * 128 + ((ks * 4 + fq) ^ kswz) * 16)
                                  : *(const bf16x8*)(sb + AT_RP + kr * 64 + (fq ^ rswz) * 16);
        }
    __builtin_amdgcn_sched_barrier(0);
    f32x4 s[2][2][2];
#pragma unroll
    for (int qt = 0; qt < 2; ++qt)
#pragma unroll
      for (int s2 = 0; s2 < 2; ++s2)
#pragma unroll
        for (int tt = 0; tt < 2; ++tt) s[qt][s2][tt] = f32x4{0.f, 0.f, 0.f, 0.f};
    __builtin_amdgcn_s_setprio(1);
#pragma unroll
    for (int ks = 0; ks < 3; ++ks)
#pragma unroll
      for (int s2 = 0; s2 < 2; ++s2)
#pragma unroll
        for (int tt = 0; tt < 2; ++tt)
#pragma unroll
          for (int qt = 0; qt < 2; ++qt)
            s[qt][s2][tt] = __builtin_amdgcn_mfma_f32_16x16x32_bf16(kf[ks][s2][tt], qfrag[qt][ks], s[qt][s2][tt], 0, 0, 0);
    __builtin_amdgcn_s_setprio(0);
    __builtin_amdgcn_sched_barrier(0);
    bf16x4 vf[2][4][2];
#pragma unroll
    for (int s2 = 0; s2 < 2; ++s2)
#pragma unroll
      for (int dt = 0; dt < 4; ++dt) {
        const int c0 = (kh * 2 + s2) * 4 + (fq >> 1);
        vf[s2][dt][0] = *(const bf16x4*)(sb + AT_VT + (dt * 16 + fr) * 256 + (((c0) ^ fr) * 16) + (fq & 1) * 8);
        vf[s2][dt][1] = *(const bf16x4*)(sb + AT_VT + (dt * 16 + fr) * 256 + (((c0 + 2) ^ fr) * 16) + (fq & 1) * 8);
      }
    __builtin_amdgcn_sched_barrier(0);
    bf16x8 pfr[2][2];
#pragma unroll
    for (int qt = 0; qt < 2; ++qt) {
      float mx = -1e30f;
#pragma unroll
      for (int s2 = 0; s2 < 2; ++s2)
#pragma unroll
        for (int tt = 0; tt < 2; ++tt)
          mx = fmaxf(mx, fmaxf(fmaxf(s[qt][s2][tt][0], s[qt][s2][tt][1]), fmaxf(s[qt][s2][tt][2], s[qt][s2][tt][3])));
      mx = fmaxf(mx, shx(mx, 16, lane));
      mx = fmaxf(mx, shx(mx, 32, lane));
      const float mnew = fmaxf(mrun[qt], mx);
      const float alpha = __builtin_amdgcn_exp2f((mrun[qt] - mnew) * sc);
      mrun[qt] = mnew;
      const float mb = mnew * sc;
      float ps = 0.f;
#pragma unroll
      for (int s2 = 0; s2 < 2; ++s2) {
        float pv[8];
#pragma unroll
        for (int tt = 0; tt < 2; ++tt)
#pragma unroll
          for (int j = 0; j < 4; ++j) { pv[tt * 4 + j] = __builtin_amdgcn_exp2f(s[qt][s2][tt][j] * sc - mb); ps += pv[tt * 4 + j]; }
        union { bf16x8 v; unsigned u[4]; } pf;
        pf.u[0] = pk2(pv[0], pv[1]); pf.u[1] = pk2(pv[2], pv[3]); pf.u[2] = pk2(pv[4], pv[5]); pf.u[3] = pk2(pv[6], pv[7]);
        pfr[qt][s2] = pf.v;
      }
      lsum[qt] = lsum[qt] * alpha + ps;
#pragma unroll
      for (int dt = 0; dt < 4; ++dt) o[qt][dt] *= alpha;
    }
    __builtin_amdgcn_sched_barrier(0);
    __builtin_amdgcn_s_setprio(1);
#pragma unroll
    for (int s2 = 0; s2 < 2; ++s2)
#pragma unroll
      for (int dt = 0; dt < 4; ++dt) {
        const bf16x8 vfr = __builtin_shufflevector(vf[s2][dt][0], vf[s2][dt][1], 0, 1, 2, 3, 4, 5, 6, 7);
#pragma unroll
        for (int qt = 0; qt < 2; ++qt) o[qt][dt] = __builtin_amdgcn_mfma_f32_16x16x32_bf16(vfr, pfr[qt][s2], o[qt][dt], 0, 0, 0);
      }
    __builtin_amdgcn_s_setprio(0);
    __builtin_amdgcn_sched_barrier(0);
    buf = buf == 2 ? 0 : buf + 1;
  }
#pragma unroll
  for (int qt = 0; qt < 2; ++qt) { lsum[qt] += shx(lsum[qt], 16, lane); lsum[qt] += shx(lsum[qt], 32, lane); }
  asm volatile("s_waitcnt lgkmcnt(0)" ::: "memory");
  __builtin_amdgcn_s_barrier();
  asm volatile("" ::: "memory");
  float* xch = (float*)smem + (size_t)(qg * 64 + lane) * 40;
  if (kh == 1) {
#pragma unroll
    for (int qt = 0; qt < 2; ++qt) {
#pragma unroll
      for (int dt = 0; dt < 4; ++dt) *(f32x4*)(xch + qt * 20 + dt * 4) = o[qt][dt];
      xch[qt * 20 + 16] = mrun[qt];
      xch[qt * 20 + 17] = lsum[qt];
    }
  }
  asm volatile("s_waitcnt lgkmcnt(0)" ::: "memory");
  __builtin_amdgcn_s_barrier();
  asm volatile("" ::: "memory");
  if (kh == 0) {
#pragma unroll
    for (int qt = 0; qt < 2; ++qt) {
      const float m1 = xch[qt * 20 + 16], l1 = xch[qt * 20 + 17];
      const float mm = fmaxf(mrun[qt], m1);
      const float a0 = __builtin_amdgcn_exp2f((mrun[qt] - mm) * sc), a1 = __builtin_amdgcn_exp2f((m1 - mm) * sc);
      const float inv = 1.f / (lsum[qt] * a0 + l1 * a1);
      u16* op = (u16*)(ws + OFF_O) + (size_t)(tokb + qt * 16 + fr) * 512 + h * 64 + fq * 4;
#pragma unroll
      for (int dt = 0; dt < 4; ++dt) {
        const f32x4 o1 = *(const f32x4*)(xch + qt * 20 + dt * 4);
        st_bf4(op + dt * 16, (o[qt][dt][0] * a0 + o1[0] * a1) * inv, (o[qt][dt][1] * a0 + o1[1] * a1) * inv,
               (o[qt][dt][2] * a0 + o1[2] * a1) * inv, (o[qt][dt][3] * a0 + o1[3] * a1) * inv);
      }
    }
  }
  asm volatile("s_waitcnt lgkmcnt(0)" ::: "memory");
  __builtin_amdgcn_s_barrier();
  asm volatile("" ::: "memory");
}

DEVI void phase_attn_amix(const Params& p, int l, char* smem) {
  for (int bt = blockIdx.x; bt < 512; bt += gridDim.x) attn_block(p, bt, smem);
}

DEVI void phase_merge(const Params& p, int l, char* smem) {
  char* ws = PWS;
  const int tid = tidx(), wid = tid >> 6, lane = tid & 63, wr = wid >> 1, wc = wid & 1, fr = lane & 15, fq = lane >> 4;
  const u16* YC = (const u16*)(ws + OFF_YCS);
  const u16* W4 = (const u16*)(ws + OFF_W4F + l * SZ_W4F);
  const u16* O = (const u16*)(ws + OFF_O);
  const u16* WA = (const u16*)(ws + OFF_WAP + l * SZ_WAP);
  const u16* sgf = (const u16*)(ws + OFF_SGF);
  const u16* sga = (const u16*)(ws + OFF_SGA);
  u16* mg = (u16*)(ws + OFF_H);
  const int G = gridDim.x;
  uint2 stash[4][4];
  auto decode = [&](int idx, int& pair, int& part) { const int t = idx / G, b = idx - t * G; pair = b + (t >> 1) * G; part = t & 1; };
  auto get = [&](int idx) {
    int pair, part; decode(idx, pair, part);
    int tm, tn; const bool ok = pair < 256 && tile_xcd(pair, 32, 8, tm, tn);
    if (!ok) return TileDesc{nullptr, nullptr, 0, 0, 0};
    return part == 0 ? TileDesc{YC + (size_t)tm * TM * 512, W4 + (size_t)tn * 128 * 512, 512, 512, 8}
                     : TileDesc{O + (size_t)tm * TM * 512, WA + (size_t)tn * 128 * 512, 512, 512, 8};
  };
  auto epi = [&](int idx, f32x4 (&acc)[4][4]) {
    int pair, part; decode(idx, pair, part);
    int tm, tn; tile_xcd(pair, 32, 8, tm, tn);
#pragma unroll
    for (int m = 0; m < 4; ++m) {
      const int row = tm * TM + wr * 64 + m * 16 + fr;
#pragma unroll
      for (int n = 0; n < 4; ++n) {
        const int col = tn * 128 + wc * 64 + n * 16 + fq * 4;
        if (part == 0) {
          const uint2 g = *(const uint2*)(sgf + (size_t)row * D + col);
          stash[m][n].x = pk2(bf2f(g.x & 0xffff) * acc[m][n][0], bf2f(g.x >> 16) * acc[m][n][1]);
          stash[m][n].y = pk2(bf2f(g.y & 0xffff) * acc[m][n][2], bf2f(g.y >> 16) * acc[m][n][3]);
        } else {
          const uint2 g = *(const uint2*)(sga + (size_t)row * D + col);
          const uint2 a = stash[m][n];
          st_bf4(mg + (size_t)row * LDH + col, bf2f(a.x & 0xffff) + bf2f(g.x & 0xffff) * acc[m][n][0],
                 bf2f(a.x >> 16) + bf2f(g.x >> 16) * acc[m][n][1], bf2f(a.y & 0xffff) + bf2f(g.y & 0xffff) * acc[m][n][2],
                 bf2f(a.y >> 16) + bf2f(g.y >> 16) * acc[m][n][3]);
        }
      }
    }
  };
  gemm_stream(2 * ((256 + G - 1) / G) * G, get, epi, smem);
}

#define XB_TMO      128
#define XB_XCNT(j)  (256  + 64 * (j))
#define XB_XSUB(j)  (1280 + 64 * (j))
#define XB_XGEN(j)  (2304 + 64 * (j))
#define XB_TOP      3328
#define XB_TOPGEN   3392
#define XCD_BAR_WORDS 3456
#define XB_SPIN_CAP (1u << 18)
#define LAS __attribute__((address_space(3)))
DEVI unsigned xb_ld(unsigned* p)              { return __hip_atomic_load(p, __ATOMIC_RELAXED, __HIP_MEMORY_SCOPE_AGENT); }
DEVI unsigned xb_add(unsigned* p, unsigned v) { return __hip_atomic_fetch_add(p, v, __ATOMIC_RELAXED, __HIP_MEMORY_SCOPE_AGENT); }
DEVI unsigned xb_xcc_id() { return (unsigned)__builtin_amdgcn_s_getreg((3 << 11) | 20) & 0xFu; }
#define XB_SPIN(cond, bar) do { unsigned _sp = 0; while (cond) { __builtin_amdgcn_s_sleep(1); \
    if ((++_sp & 255u) == 0u) { if (xb_ld(&(bar)[XB_TMO])) break; if (_sp > XB_SPIN_CAP) { atomicAdd(&(bar)[XB_TMO], 1u); break; } } } } while (0)
struct XcdBarrier { unsigned* bar; unsigned x; volatile LAS unsigned* st; };
DEVI XcdBarrier xcd_barrier_post(unsigned* bar, volatile LAS unsigned* st) {
  XcdBarrier b; b.bar = bar; b.x = xb_xcc_id(); b.st = st;
  if (threadIdx.x == 0) (void)xb_add(&bar[XB_XCNT(b.x)], 1u);
  return b;
}
DEVI void xcd_barrier_complete(unsigned* bar, unsigned x, unsigned& nloc, unsigned& nx) {
  const unsigned G = gridDim.x * gridDim.y * gridDim.z;
  unsigned sum, cnt, mine, sp = 0u;
  for (;;) {
    sum = 0u; cnt = 0u; mine = 0u;
#pragma unroll
    for (unsigned j = 0; j < 16; ++j) { const unsigned c = xb_ld(&bar[XB_XCNT(j)]); sum += c; cnt += (c > 0u) ? 1u : 0u; mine = (j == x) ? c : mine; }
    if (sum == G) break;
    __builtin_amdgcn_s_sleep(1);
    if ((++sp & 255u) == 0u) { if (xb_ld(&bar[XB_TMO])) break; if (sp > XB_SPIN_CAP) { atomicAdd(&bar[XB_TMO], 1u); break; } }
  }
  nloc = mine > 0u ? mine : 1u; nx = cnt > 0u ? cnt : 1u;
}
DEVI void xcd_barrier(const XcdBarrier& b) {
  asm volatile("s_waitcnt vmcnt(0)" ::: "memory");
  __syncthreads();
  if (threadIdx.x == 0) {
    unsigned* bar = b.bar;
    __builtin_amdgcn_s_waitcnt(0);
    unsigned nloc = b.st[0], nx = b.st[1];
    if (nloc == 0u) { xcd_barrier_complete(bar, b.x, nloc, nx); b.st[0] = nloc; b.st[1] = nx; }
    const unsigned old = xb_add(&bar[XB_XSUB(b.x)], 1u);
    const unsigned gen = old / nloc;
    if (old + 1u == (gen + 1u) * nloc) {
      __builtin_amdgcn_fence(__ATOMIC_RELEASE, "agent");
      asm volatile("s_waitcnt vmcnt(0)" ::: "memory");
      const unsigned og = xb_add(&bar[XB_TOP], 1u);
      const unsigned tg = og / nx;
      if (og + 1u == (tg + 1u) * nx) xb_add(&bar[XB_TOPGEN], 1u);
      else XB_SPIN(xb_ld(&bar[XB_TOPGEN]) == tg, bar);
      __builtin_amdgcn_fence(__ATOMIC_ACQUIRE, "agent");
      xb_add(&bar[XB_XGEN(b.x)], 1u);
      asm volatile("s_waitcnt vmcnt(0)" ::: "memory");
    } else {
      XB_SPIN(xb_ld(&bar[XB_XGEN(b.x)]) == gen, bar);
      __builtin_amdgcn_fence(__ATOMIC_ACQUIRE, "agent");
      asm volatile("s_waitcnt vmcnt(0)" ::: "memory");
    }
  }
  __syncthreads();
}

constexpr int NPH = 26;

DEVI void run_phase(const Params& p, int ph, char* smem) {
  if (ph == 0) { phase_prep(p, smem); return; }
  if (ph == NPH - 1) { phase_final(p); return; }
  const int l = (ph - 1) / 12, s = (ph - 1) % 12;
  switch (s) {
    case 0: phase_norm(p, l, 0, l == 0); break;
    case 1: phase_gu(p, l, 0, smem); break;
    case 2: phase_resid(p, (const u16*)(PWS + OFF_ACT), FF, FF, (const u16*)(PWS + OFF_WD + (l * 2 + 0) * SZ_WD), l, 2, 0.5f, l == 0, smem); break;
    case 3: phase_norm(p, l, 1, false); phase_cachecopy(p, l); break;
    case 4: phase_win(p, l, smem); break;
    case 5: phase_qkv_dft(p, l, smem); break;
    case 6: phase_attn_amix(p, l, smem); break;
    case 7: phase_merge(p, l, smem); break;
    case 8: phase_resid(p, (const u16*)(PWS + OFF_H), LDH, D, (const u16*)(PWS + OFF_WOUT + l * SZ_WOUT), l, 5, 1.0f, false, smem); break;
    case 9: phase_norm(p, l, 2, false); break;
    case 10: phase_gu(p, l, 1, smem); break;
    case 11: phase_resid(p, (const u16*)(PWS + OFF_ACT), FF, FF, (const u16*)(PWS + OFF_WD + (l * 2 + 1) * SZ_WD), l, 8, 0.5f, false, smem); break;
  }
}

__global__ void __launch_bounds__(512) mega(Params p, int ph0, int ph1) {
  extern __shared__ __attribute__((aligned(16))) char smem[];
  if (ph1 > 4096) cg::this_grid().sync();
  volatile LAS unsigned* st = (volatile LAS unsigned*)(smem + LDS_BYTES);
  if (threadIdx.x == 0) { st[0] = 0u; st[1] = 0u; st[2] = 0u; st[3] = 0u; }
  __syncthreads();
  (void)xcd_barrier_post((unsigned*)(p.ws + OFF_BAR), st);
  for (int ph = ph0; ph < ph1; ++ph) {
    run_phase(p, ph, smem);
#ifdef PROBE_S
    if (ph >= 1 && ph < NPH - 1 && ((ph - 1) % 12) == PROBE_S) run_phase(p, ph, smem);
#endif
#ifdef PROBE_PH
    if (ph == PROBE_PH) run_phase(p, ph, smem);
#endif
    if (ph + 1 < ph1) {
      {
        XcdBarrier xb; xb.bar = (unsigned*)(PWS + OFF_BAR); xb.x = xb_xcc_id();
        xb.st = (volatile LAS unsigned*)(smem + LDS_BYTES);
        xcd_barrier(xb);
      }

    }
  }
}

extern "C" void kernel_launch(void* const* d_in, const int* in_sizes, int n_in, void* d_out, int out_size, void* d_ws,
                              size_t ws_size, hipStream_t stream) {
  static int grid_blocks = 0;
  if (!grid_blocks) {
    int dev = 0, cus = 0, per_cu = 0;
    hipGetDevice(&dev);
    hipDeviceGetAttribute(&cus, hipDeviceAttributeMultiprocessorCount, dev);
    hipFuncSetAttribute((const void*)mega, hipFuncAttributeMaxDynamicSharedMemorySize, LDS_BYTES + 16);
    hipOccupancyMaxActiveBlocksPerMultiprocessor(&per_cu, mega, NT, LDS_BYTES + 16);
    if (per_cu < 1) per_cu = 1;
    grid_blocks = cus * per_cu;
  }
  if (ws_size < WS_TOTAL) { fprintf(stderr, "workspace too small: %zu < %zu\n", ws_size, (size_t)WS_TOTAL); return; }
  Params p{};
  for (int i = 0; i < 26; ++i) p.in[i] = (const float*)d_in[i];
  p.out = (float*)d_out;
  p.ws = (char*)d_ws;
  int ph0 = 0, ph1 = NPH;
  hipMemsetAsync((char*)d_ws + OFF_BAR, 0, 16384, stream);
  void* args[] = {&p, &ph0, &ph1};
  hipError_t e = hipLaunchCooperativeKernel((void*)mega, dim3(grid_blocks), dim3(NT), args, LDS_BYTES + 16, stream);
  if (e != hipSuccess) fprintf(stderr, "cooperative launch failed: %s (grid %d)\n", hipGetErrorString(e), grid_blocks);
}
```
